# Optimizing an MI355X kernel written in HIP

```python
import jax, jax.numpy as jnp
from jax import lax
import numpy as np

D_MODEL = 2048
BATCH = 4
SEQ = 4096
DEPTH = 2

POOL_WIDTH = D_MODEL // 2
POOL_WINDOWS = (2, 4, 8, 16)
POOL_GROUP = POOL_WIDTH // len(POOL_WINDOWS)
HEAD_DIM = 128
N_HEADS = (D_MODEL - POOL_WIDTH) // HEAD_DIM
N_KV = 2
GROUP_SIZE = N_HEADS // N_KV
ATT_WIDTH = N_HEADS * HEAD_DIM
KV_WIDTH = N_KV * HEAD_DIM
CMP_LEN = 32
CMP_STRIDE = 16
SLC_LEN = 64
SLC_TOPK = 16
WIN = 512
Q_BLOCK = 128
SLC_Q_CHUNK = 32
D_FF = -(-8 * D_MODEL // (3 * 256)) * 256
IN_COLS = POOL_WIDTH + ATT_WIDTH + 6 * KV_WIDTH + 3 * N_HEADS
NORM_EPS = 1e-6
NEG_INF = -1e30
FORCE_BONUS = 1e3

kernel_name = "hymba_pool_nsa_alibi_adaln_block"


def rmsnorm(x, g):
    x32 = x.astype(jnp.float32)
    y = x32 * lax.rsqrt(jnp.mean(x32 * x32, axis=-1, keepdims=True) + NORM_EPS)
    return (y * g.astype(jnp.float32)).astype(x.dtype)


def masked_softmax(s, mask):
    s = jnp.where(mask, s, NEG_INF)
    p = jax.nn.softmax(s, axis=-1)
    return jnp.where(mask, p, 0.0)


def alibi_slopes():
    sl = 2.0 ** (-8.0 * np.arange(1, N_HEADS + 1) / N_HEADS)
    return jnp.asarray(sl, jnp.float32).reshape(N_KV, GROUP_SIZE)


def split_points():
    sizes = [POOL_WIDTH, ATT_WIDTH] + [KV_WIDTH] * 6 + [3 * N_HEADS]
    return [int(v) for v in np.cumsum(sizes)[:-1]]


def pool_mixer(u, w_pool, pool_scale):
    B, T, _ = u.shape
    u32 = u.astype(jnp.float32)
    cs = jnp.pad(jnp.cumsum(u32, axis=1), ((0, 0), (1, 0), (0, 0)))
    t = np.arange(T)
    outs = []
    for gi, w in enumerate(POOL_WINDOWS):
        sl = slice(gi * POOL_GROUP, (gi + 1) * POOL_GROUP)
        c_g = cs[..., sl]
        lo = np.maximum(t + 1 - w, 0)
        cnt = jnp.asarray((t + 1 - lo).astype(np.float32))
        mean = (c_g[:, 1:] - c_g[:, lo]) / cnt[None, :, None]
        outs.append(mean - u32[..., sl])
    pooled = jnp.stack(outs, axis=2).astype(u.dtype)
    mixed = jnp.einsum('btgc,gcd->btgd', pooled, w_pool)
    return mixed.reshape(B, T, POOL_WIDTH) * pool_scale


def compress(k, pe, w1, w2):
    B, T, G, dh = k.shape
    n_cmp = (T - CMP_LEN) // CMP_STRIDE + 1
    idx = np.arange(n_cmp)[:, None] * CMP_STRIDE + np.arange(CMP_LEN)[None, :]
    blocks = k[:, idx] + pe[None, None, :, None, :]
    flat = blocks.transpose(0, 1, 3, 2, 4).reshape(B, n_cmp, G, CMP_LEN * dh)
    return jax.nn.silu(flat @ w1) @ w2


def nsa_mixer(q, kc, vc, ks, vs, kw, vw, gate_logits, q_gain, k_gain, pe_cmp, w_cmp1, w_cmp2):
    B, T = q.shape[:2]
    G, R, dh = N_KV, GROUP_SIZE, HEAD_DIM
    scale = dh ** -0.5
    slopes = alibi_slopes()
    qg = rmsnorm(q, q_gain).reshape(B, T, G, R, dh)
    t = np.arange(T)

    kcmp = rmsnorm(compress(kc, pe_cmp[0], w_cmp1[0], w_cmp2[0]), k_gain[0])
    vcmp = compress(vc, pe_cmp[1], w_cmp1[1], w_cmp2[1])
    n_cmp = kcmp.shape[1]
    end_pos = np.arange(n_cmp) * CMP_STRIDE + CMP_LEN - 1
    dist_c = (t[:, None] - end_pos[None, :]).astype(np.float32)
    s = jnp.einsum('btgrd,bcgd->bgrtc', qg, kcmp).astype(jnp.float32) * scale
    s = s - slopes[None, :, :, None, None] * jnp.asarray(dist_c)[None, None, None]
    p_cmp = masked_softmax(s, jnp.asarray(dist_c >= 0)[None, None, None])
    o_cmp = jnp.einsum('bgrtc,bcgd->btgrd', p_cmp.astype(vcmp.dtype), vcmp)

    n_slc = T // SLC_LEN
    n_sel = min(SLC_TOPK, n_slc)
    cst = np.arange(n_cmp) * CMP_STRIDE
    sst = np.arange(n_slc) * SLC_LEN
    overlap = ((cst[:, None] < sst[None, :] + SLC_LEN) & (cst[:, None] + CMP_LEN > sst[None, :]))
    imp = jnp.einsum('bgrtc,cs->bgts', p_cmp, jnp.asarray(overlap.astype(np.float32)))
    cur = t // SLC_LEN
    jb = np.arange(n_slc)
    valid = sst[None, :] <= t[:, None]
    forced = (jb[None, :] == 0) | (jb[None, :] == cur[:, None]) | (jb[None, :] == cur[:, None] - 1)
    score = jnp.where(jnp.asarray(valid), imp + FORCE_BONUS * jnp.asarray(forced.astype(np.float32)), NEG_INF)
    idx = lax.top_k(score, n_sel)[1]

    ks_n = rmsnorm(ks, k_gain[1])
    kblk = ks_n.reshape(B, n_slc, SLC_LEN, G, dh).transpose(0, 3, 1, 2, 4)
    vblk = vs.reshape(B, n_slc, SLC_LEN, G, dh).transpose(0, 3, 1, 2, 4)
    nq = T // SLC_Q_CHUNK
    q_ch = qg.reshape(B, nq, SLC_Q_CHUNK, G, R, dh).transpose(1, 0, 3, 2, 4, 5)
    idx_ch = idx.reshape(B, G, nq, SLC_Q_CHUNK, n_sel).transpose(2, 0, 1, 3, 4)
    t_ch = jnp.asarray(t.reshape(nq, SLC_Q_CHUNK).astype(np.int32))
    bi = jnp.arange(B)[:, None, None, None]
    gi = jnp.arange(G)[None, :, None, None]
    offs = jnp.arange(SLC_LEN, dtype=jnp.int32)

    def sel_chunk(args):
        qc, ic, tc = args
        ksel = kblk[bi, gi, ic].reshape(B, G, SLC_Q_CHUNK, n_sel * SLC_LEN, dh)
        vsel = vblk[bi, gi, ic].reshape(B, G, SLC_Q_CHUNK, n_sel * SLC_LEN, dh)
        pos = (ic[..., None] * SLC_LEN + offs).reshape(B, G, SLC_Q_CHUNK, n_sel * SLC_LEN)
        dist = tc[None, None, :, None] - pos
        sc = jnp.einsum('bgqrd,bgqkd->bgrqk', qc, ksel).astype(jnp.float32) * scale
        sc = sc - slopes[None, :, :, None, None] * dist[:, :, None].astype(jnp.float32)
        pr = masked_softmax(sc, (dist >= 0)[:, :, None])
        return jnp.einsum('bgrqk,bgqkd->bqgrd', pr.astype(vsel.dtype), vsel)

    o_slc = lax.map(sel_chunk, (q_ch, idx_ch, t_ch))
    o_slc = o_slc.transpose(1, 0, 2, 3, 4, 5).reshape(B, T, G, R, dh)

    kw_n = rmsnorm(kw, k_gain[2])
    nb = T // Q_BLOCK
    nwb = WIN // Q_BLOCK
    def band(a):
        ab = jnp.pad(a.reshape(B, nb, Q_BLOCK, G, dh), ((0, 0), (nwb, 0), (0, 0), (0, 0), (0, 0)))
        return jnp.concatenate([ab[:, i:i + nb] for i in range(nwb + 1)], axis=2)
    kband, vband = band(kw_n), band(vw)
    jq = np.arange(nb)
    kpos = (jq[:, None] - nwb) * Q_BLOCK + np.arange((nwb + 1) * Q_BLOCK)[None, :]
    tq = jq[:, None] * Q_BLOCK + np.arange(Q_BLOCK)[None, :]
    dist_w = tq[:, :, None] - kpos[:, None, :]
    mask_w = (dist_w >= 0) & (dist_w < WIN) & (kpos[:, None, :] >= 0)
    qw = qg.reshape(B, nb, Q_BLOCK, G, R, dh)
    sw = jnp.einsum('bjqgrd,bjkgd->bjgrqk', qw, kband).astype(jnp.float32) * scale
    sw = sw - slopes[None, None, :, :, None, None] * jnp.asarray(dist_w.astype(np.float32))[None, :, None, None]
    pw = masked_softmax(sw, jnp.asarray(mask_w)[None, :, None, None])
    o_win = jnp.einsum('bjgrqk,bjkgd->bjqgrd', pw.astype(vband.dtype), vband).reshape(B, T, G, R, dh)

    g = jax.nn.sigmoid(gate_logits.reshape(B, T, G, R, 3))
    o = g[..., 0:1] * o_cmp + g[..., 1:2] * o_slc + g[..., 2:3] * o_win
    return o.reshape(B, T, ATT_WIDTH)


def setup_inputs(seed: int = 0) -> dict:
    key = jax.random.key(seed)
    ks = jax.random.split(key, 17)
    f32 = jnp.float32
    nrm = lambda k, shape, s: jax.random.normal(k, shape, f32) * s
    L = DEPTH
    return {
        "x": nrm(ks[0], (BATCH, SEQ, D_MODEL), 1.0),
        "c": nrm(ks[1], (BATCH, D_MODEL), 1.0),
        "w_ada": nrm(ks[2], (L, D_MODEL, 6 * D_MODEL), 0.5 * D_MODEL ** -0.5),
        "b_ada": nrm(ks[3], (L, 6 * D_MODEL), 0.02),
        "norm_g": 1.0 + nrm(ks[4], (L, 2, D_MODEL), 0.05),
        "w_in": nrm(ks[5], (L, D_MODEL, IN_COLS), D_MODEL ** -0.5),
        "q_gain": 1.0 + nrm(ks[6], (L, HEAD_DIM), 0.05),
        "k_gain": 1.0 + nrm(ks[7], (L, 3, HEAD_DIM), 0.05),
        "pe_cmp": nrm(ks[8], (L, 2, CMP_LEN, HEAD_DIM), 0.5),
        "w_cmp1": nrm(ks[9], (L, 2, CMP_LEN * HEAD_DIM, HEAD_DIM), (CMP_LEN * HEAD_DIM) ** -0.5),
        "w_cmp2": nrm(ks[10], (L, 2, HEAD_DIM, HEAD_DIM), HEAD_DIM ** -0.5),
        "w_pool": nrm(ks[11], (L, len(POOL_WINDOWS), POOL_GROUP, POOL_GROUP), POOL_GROUP ** -0.5),
        "pool_scale": 1.0 + nrm(ks[12], (L, POOL_WIDTH), 0.05),
        "w_out": nrm(ks[13], (L, D_MODEL, D_MODEL), D_MODEL ** -0.5),
        "w_gate_up": nrm(ks[14], (L, D_MODEL, 2 * D_FF), D_MODEL ** -0.5),
        "w_down": nrm(ks[15], (L, D_FF, D_MODEL), D_FF ** -0.5),
    }


def reference(x, c, w_ada, b_ada, norm_g, w_in, q_gain, k_gain, pe_cmp, w_cmp1, w_cmp2,
              w_pool, pool_scale, w_out, w_gate_up, w_down):
    B, T, _ = x.shape
    cond = jax.nn.silu(c)
    pts = split_points()
    for l in range(DEPTH):
        mod = (cond @ w_ada[l] + b_ada[l])[:, None, :]
        sh1, sc1, g1, sh2, sc2, g2 = jnp.split(mod, 6, axis=-1)
        h = rmsnorm(x, norm_g[l, 0]) * (1.0 + sc1) + sh1
        proj = h @ w_in[l]
        u, q, kc, vc, ksl, vsl, kwn, vwn, gl = jnp.split(proj, pts, axis=-1)
        kv = lambda a: a.reshape(B, T, N_KV, HEAD_DIM)
        a_out = pool_mixer(u, w_pool[l], pool_scale[l])
        o_out = nsa_mixer(q.reshape(B, T, N_HEADS, HEAD_DIM), kv(kc), kv(vc), kv(ksl), kv(vsl),
                          kv(kwn), kv(vwn), gl, q_gain[l], k_gain[l], pe_cmp[l],
                          w_cmp1[l], w_cmp2[l])
        x = x + g1 * (jnp.concatenate([a_out, o_out], axis=-1) @ w_out[l])
        h2 = rmsnorm(x, norm_g[l, 1]) * (1.0 + sc2) + sh2
        gate, up = jnp.split(h2 @ w_gate_up[l], 2, axis=-1)
        x = x + g2 * ((jax.nn.silu(gate) * up) @ w_down[l])
    return x
```

```cpp
#include <hip/hip_runtime.h>
#include <hip/hip_cooperative_groups.h>
#include <cstdio>
#include <cstdint>
namespace cg = cooperative_groups;

#ifndef MK_SINGLE
#define MK_SINGLE 1
#endif

#ifndef PROBE
#define PROBE 0
#endif
#define LAS __attribute__((address_space(3)))
typedef unsigned short bf16_t;
typedef short bf16x8 __attribute__((ext_vector_type(8)));
typedef short s16x4 __attribute__((ext_vector_type(4)));
typedef float f32x4 __attribute__((ext_vector_type(4)));
typedef float f32x2 __attribute__((ext_vector_type(2)));
typedef float f32x16 __attribute__((ext_vector_type(16)));
typedef unsigned u32x4 __attribute__((ext_vector_type(4)));
typedef unsigned u32x2 __attribute__((ext_vector_type(2)));
typedef __bf16 bf16x2n __attribute__((ext_vector_type(2)));
#define DI __device__ __forceinline__

constexpr int D = 2048, NBATCH = 4, T = 4096, M = NBATCH * T, DEPTH = 2;
constexpr int INC = 3608, PWID = 3072, VTR = 768, WINR = 3840, DFF = 5632, NGU = 2 * DFF, MODW = 6 * D;
constexpr int PC_Q = 1024, PC_KC = 2048, PC_VC = 2304, PC_KS = 2560, PC_KW = 2816;
constexpr int VR_VS = 0, VR_VW = 256, VR_GL = 512;
constexpr int NPH = 1 + 8 * DEPTH;
constexpr int GRID = 256;

constexpr size_t MiB = 1u << 20;
constexpr size_t WS_MOD = 0;
constexpr size_t WS_BIAS1 = 512 * 1024;
constexpr size_t WS_BAR = 768 * 1024;
constexpr size_t WS_W = 1 * MiB, WL = 93 * MiB;
constexpr size_t WO_IN = 0, WO_OUT = 15 * MiB, WO_GU = 23 * MiB, WO_DOWN = 67 * MiB, WO_POOL = 89 * MiB, WO_C1 = 90 * MiB, WO_C2 = 92 * MiB;
static_assert(WO_IN + (size_t)WINR * D * 2 <= WO_OUT && WO_OUT + (size_t)D * D * 2 <= WO_GU && WO_GU + (size_t)NGU * D * 2 <= WO_DOWN && WO_DOWN + (size_t)D * DFF * 2 <= WO_POOL &&
              WO_POOL + 4 * 65536 * 2 <= WO_C1 && WO_C1 + (size_t)2 * 128 * 4096 * 2 <= WO_C2 && WO_C2 + 2 * 128 * 128 * 2 <= WL, "weight map");
constexpr size_t WS_H = 187 * MiB;
constexpr size_t WS_P = 251 * MiB;
constexpr size_t WS_VT = 347 * MiB;
constexpr size_t WS_POOLED = 371 * MiB;
constexpr size_t WS_CONCAT = 403 * MiB;
constexpr size_t WS_KCMP = 467 * MiB;
constexpr size_t WS_VCMP = 467 * MiB + 512 * 1024;
constexpr size_t WS_ACT = WS_P;
constexpr size_t WS_END = 468 * MiB;
static_assert(WS_W + 2 * WL <= WS_H && WS_H + (size_t)M * D * 2 <= WS_P && WS_P + (size_t)M * PWID * 2 <= WS_VT && WS_VT + (size_t)VTR * M * 2 <= WS_POOLED &&
              WS_POOLED + (size_t)M * 1024 * 2 <= WS_CONCAT && WS_CONCAT + (size_t)M * D * 2 <= WS_KCMP, "ws map");
static_assert(WS_ACT + (size_t)M * DFF * 2 <= WS_KCMP, "act overlay");

constexpr int LDS_BYTES = 155648;

struct Params {
    const float *x, *c, *w_ada, *b_ada, *norm_g, *w_in, *q_gain, *k_gain, *pe_cmp, *w_cmp1, *w_cmp2, *w_pool, *pool_scale, *w_out, *w_gate_up, *w_down;
    float* out; unsigned char* ws; int ph_lo, ph_hi;
};

DI int lane_id_() { unsigned m = ~0u; asm volatile("" : "+s"(m)); return (int)__builtin_amdgcn_mbcnt_hi(m, __builtin_amdgcn_mbcnt_lo(m, 0u)); }
#define TID_FROM_WV(wv) int tid = (wv) * 64 + lane_id_(); asm volatile("" : "+v"(tid));
DI unsigned pk2(float lo, float hi) { f32x2 v = {lo, hi}; bf16x2n b = __builtin_convertvector(v, bf16x2n); return __builtin_bit_cast(unsigned, b); }
DI float bf2f(unsigned short u) { return __builtin_bit_cast(float, (unsigned)u << 16); }
DI float bflo(unsigned u) { return __builtin_bit_cast(float, u << 16); }
DI float bfhi(unsigned u) { return __builtin_bit_cast(float, u & 0xffff0000u); }
DI float fast_exp2(float x) { return __builtin_amdgcn_exp2f(x); }
DI float fast_rcp(float x) { return __builtin_amdgcn_rcpf(x); }
DI float silu_f(float x) { return x * fast_rcp(1.f + fast_exp2(-1.44269504f * x)); }
DI float sigmoid_f(float x) { return fast_rcp(1.f + fast_exp2(-1.44269504f * x)); }

namespace pg8 {
constexpr int BM = 256, BK = 64, HALF = 128, HTB = HALF * BK * 2, NXCD = 8, WGM = 8;
DI int lds_byte(int r, int c) { const int st = (r >> 4) * 2 + (c >> 5), rr = r & 15, cc = c & 31, ob = rr * 64 + cc * 2; return st * 1024 + (ob ^ (((ob >> 9) & 1) << 5)); }
DI void stage_rc(int b, int& R, int& C) { const int st = b / 1024, sb = b % 1024, swz = sb ^ (((sb >> 9) & 1) << 5); R = (st >> 1) * 16 + swz / 64; C = (st & 1) * 32 + (swz % 64) / 2; }
DI int perm32(int rho) { const int n = rho >> 4, i = rho & 15; return 8 * (i >> 2) + 4 * n + (i & 3); }

struct Unit { const char* a; const char* b; int pm, pn; };

struct TileOrder {
    int nM, nN, nwg, G, c;
    DI void init(int nM_, int nN_, int G_, int c_) { nM = nM_; nN = nN_; nwg = nM * nN; G = G_; c = c_; }
    DI bool tile(int i, int& pm, int& pn) const {
        const long L = (long)i * G + c; if (L >= nwg) return false;
        int wgid = (int)L; { const int q = nwg / NXCD, r = nwg % NXCD, xcd = wgid % NXCD, off = wgid / NXCD; wgid = (xcd < r ? xcd * (q + 1) : r * (q + 1) + (xcd - r) * q) + off; }
        const int nig = WGM * nN, gid = wgid / nig, fm = gid * WGM, gsz = (nM - fm) < WGM ? (nM - fm) : WGM;
        pm = fm + ((wgid % nig) % gsz); pn = (wgid % nig) / gsz; return true;
    }
};

template <class Epi, class Sched>
DI void gemm_phase(const int wv, LAS unsigned char* lds, const int lda, const int ldb, const int K, const Sched& S, const Epi& E) {
    TID_FROM_WV(wv)
    const int wid = __builtin_amdgcn_readfirstlane(tid >> 6), lane = tid & 63, wr = wid >> 2, wc = wid & 3, fr = lane & 15, fq = lane >> 4;
    const int nt = K / BK;
    unsigned voffA[2], voffB[2];
#pragma unroll
    for (int i = 0; i < 2; ++i) { int R, C; stage_rc(tid * 16 + i * 8192, R, C); const int Rb = (R & ~31) + perm32(R & 31);
        voffA[i] = (unsigned)(R * lda + C * 2); voffB[i] = (unsigned)(Rb * ldb + C * 2); }
    const size_t kstep = (size_t)(BK * 2);
    const size_t hstepA = (size_t)HALF * lda, hstepB = (size_t)HALF * ldb;
    const unsigned ldsw = (unsigned)wid * 1024u;
    const int aoff = lds_byte(wr * 64 + fr, fq * 8), boff = lds_byte(wc * 32 + fr, fq * 8);
#define PG8_SA(b, h) (((b) * 2 + (h)) * HTB)
#define PG8_SB(b, h) ((4 + (b) * 2 + (h)) * HTB)
#define PG8_STAGE(bufoff, gbase, voff) do { _Pragma("unroll") for (int _i = 0; _i < 2; ++_i) \
        __builtin_amdgcn_global_load_lds((const unsigned*)((const char*)(gbase) + (voff)[_i]), (LAS unsigned*)(lds + (bufoff) + ldsw + _i * 8192), 16, 0, 0); } while (0)
#define PG8_LDA(dst, b, h) do { _Pragma("unroll") for (int m = 0; m < 4; ++m) _Pragma("unroll") for (int k = 0; k < 2; ++k) dst[m][k] = *(const LAS bf16x8*)(lds + PG8_SA(b, h) + aoff + m * 2048 + k * 1024); } while (0)
#define PG8_LDB(dst, b, h) do { _Pragma("unroll") for (int n = 0; n < 2; ++n) _Pragma("unroll") for (int k = 0; k < 2; ++k) dst[n][k] = *(const LAS bf16x8*)(lds + PG8_SB(b, h) + boff + n * 2048 + k * 1024); } while (0)
#define PG8_MMA(ai, bj, At, Bt) do { __builtin_amdgcn_s_setprio(1); _Pragma("unroll") for (int m = 0; m < 4; ++m) _Pragma("unroll") for (int n = 0; n < 2; ++n) _Pragma("unroll") for (int k = 0; k < 2; ++k) \
        acc[ai][bj][m][n] = __builtin_amdgcn_mfma_f32_16x16x32_bf16(Bt[n][k], At[m][k], acc[ai][bj][m][n], 0, 0, 0); __builtin_amdgcn_s_setprio(0); } while (0)
#define PG8_WAIT_V(n) asm volatile("s_waitcnt vmcnt(" #n ")" ::: "memory")
#define PG8_WAIT_L(n) asm volatile("s_waitcnt lgkmcnt(" #n ")" ::: "memory")
#define PG8_BAR __builtin_amdgcn_s_barrier()
#define PG8_SCHED __builtin_amdgcn_sched_barrier(0)
    Unit cur, nxt; int ui = 0;
    if (!S.next(0, cur)) return;
    f32x4 acc[2][2][4][2];
#pragma unroll
    for (int a = 0; a < 2; ++a)
#pragma unroll
        for (int b = 0; b < 2; ++b)
#pragma unroll
            for (int m = 0; m < 4; ++m)
#pragma unroll
                for (int n = 0; n < 2; ++n) acc[a][b][m][n] = (f32x4){0.f, 0.f, 0.f, 0.f};
    bf16x8 At[4][2], B0[2][2], B1[2][2];
    const char* cA = cur.a; const char* cB = cur.b;
    PG8_STAGE(PG8_SB(0, 0), cB, voffB); PG8_STAGE(PG8_SB(0, 1), cB + hstepB, voffB); PG8_STAGE(PG8_SA(0, 0), cA, voffA); PG8_STAGE(PG8_SA(0, 1), cA + hstepA, voffA);
    if (wr == 1) PG8_BAR;
    PG8_WAIT_V(2); PG8_BAR;
    PG8_STAGE(PG8_SB(1, 0), cB + kstep, voffB); PG8_STAGE(PG8_SA(1, 0), cA + kstep, voffA); PG8_STAGE(PG8_SB(1, 1), cB + hstepB + kstep, voffB);
    PG8_WAIT_V(6); PG8_BAR;
    for (;;) {
        const bool has_next = S.next(ui + 1, nxt);
        const char* nA = has_next ? nxt.a : cA; const char* nB = has_next ? nxt.b : cB;
#pragma unroll 1
        for (int t = 0; t < nt; t += 2) {
            const bool last = (t == nt - 2);
            const char* a1 = cA + (size_t)(t + 1) * kstep;
            const char* a2 = last ? nA : cA + (size_t)(t + 2) * kstep; const char* b2 = last ? nB : cB + (size_t)(t + 2) * kstep;
            const char* a3 = a2 + kstep; const char* b3 = b2 + kstep;
            PG8_LDB(B0, 0, 0); PG8_LDB(B1, 0, 1); PG8_SCHED; PG8_LDA(At, 0, 0); PG8_STAGE(PG8_SA(1, 1), a1 + hstepA, voffA);
            PG8_WAIT_V(8); PG8_WAIT_L(0); PG8_BAR; PG8_MMA(0, 0, At, B0); PG8_MMA(0, 1, At, B1); PG8_BAR; PG8_SCHED;
            PG8_LDA(At, 0, 1); PG8_STAGE(PG8_SB(0, 0), b2, voffB); PG8_STAGE(PG8_SB(0, 1), b2 + hstepB, voffB); PG8_STAGE(PG8_SA(0, 0), a2, voffA);
            PG8_WAIT_V(8); PG8_WAIT_L(0); PG8_BAR; PG8_MMA(1, 0, At, B0); PG8_MMA(1, 1, At, B1); PG8_BAR; PG8_SCHED;
            PG8_LDB(B0, 1, 0); PG8_LDB(B1, 1, 1); PG8_SCHED; PG8_LDA(At, 1, 0); PG8_STAGE(PG8_SA(0, 1), a2 + hstepA, voffA);
            PG8_WAIT_V(8); PG8_WAIT_L(0); PG8_BAR; PG8_MMA(0, 0, At, B0); PG8_MMA(0, 1, At, B1); PG8_BAR; PG8_SCHED;
            PG8_LDA(At, 1, 1); PG8_STAGE(PG8_SB(1, 0), b3, voffB); PG8_STAGE(PG8_SB(1, 1), b3 + hstepB, voffB); PG8_STAGE(PG8_SA(1, 0), a3, voffA);
            PG8_WAIT_V(8); PG8_WAIT_L(0); PG8_BAR; PG8_MMA(1, 0, At, B0); PG8_MMA(1, 1, At, B1); PG8_BAR; PG8_SCHED;
        }
        if (wr == 0) PG8_BAR;
        E(acc, cur, wr, wc, fr, fq);
        if (!has_next) break;
#pragma unroll
        for (int a = 0; a < 2; ++a)
#pragma unroll
            for (int b = 0; b < 2; ++b)
#pragma unroll
                for (int m = 0; m < 4; ++m)
#pragma unroll
                    for (int n = 0; n < 2; ++n) acc[a][b][m][n] = (f32x4){0.f, 0.f, 0.f, 0.f};
        cur = nxt; cA = nA; cB = nB; ++ui;
        if (wr == 1) PG8_BAR;
    }
    PG8_WAIT_V(0);
    PG8_BAR;
#undef PG8_SA
#undef PG8_SB
#undef PG8_STAGE
#undef PG8_LDA
#undef PG8_LDB
#undef PG8_MMA
#undef PG8_WAIT_V
#undef PG8_WAIT_L
#undef PG8_BAR
#undef PG8_SCHED
}

struct SchedProj { TileOrder o; const char* h; const char* w;
    DI bool next(int i, Unit& u) const { int pm, pn; if (!o.tile(i, pm, pn)) return false; u.pm = pm; u.pn = pn;
        const char* hp = h + (size_t)pm * (256 * 4096); const char* wp = w + (size_t)pn * (256 * 4096);
        if (pn < 12) { u.a = hp; u.b = wp; } else { u.a = wp; u.b = hp; } return true; } };
struct SchedPlain { TileOrder o; const char* A; const char* B; size_t tsA, tsB;
    DI bool next(int i, Unit& u) const { int pm, pn; if (!o.tile(i, pm, pn)) return false; u.pm = pm; u.pn = pn; u.a = A + (size_t)pm * tsA; u.b = B + (size_t)pn * tsB; return true; } };
struct SchedWeff { int G, c; const char* wbase;
    DI bool next(int i, Unit& u) const { const int L = i * G + c; if (L >= 64) return false; const int l = L >> 5, pmw = (L >> 2) & 7, g = L & 3; u.pm = l * 8 + pmw; u.pn = g;
        const char* wl_ = wbase + (size_t)l * WL; u.a = wl_ + WO_OUT + (size_t)pmw * (256 * 4096) + g * 512; u.b = wl_ + WO_POOL + (size_t)g * (65536 * 2); return true; } };
struct SchedPoolOne { int pm, pn; const char* A; const char* B;
    DI bool next(int i, Unit& u) const { if (i != 0) return false; u.pm = pm; u.pn = pn; u.a = A + (size_t)pm * (256 * 2048) + pn * 512; u.b = B + (size_t)pn * (256 * 512); return true; } };
struct SchedPool { TileOrder o; const char* A; const char* B;
    DI bool next(int i, Unit& u) const { int pm, pn; if (!o.tile(i, pm, pn)) return false; u.pm = pm; u.pn = pn; u.a = A + (size_t)pm * (256 * 2048) + pn * 512; u.b = B + (size_t)pn * (256 * 512); return true; } };

DI void store_bf16_tile(const f32x4 (&acc)[2][2][4][2], bf16_t* O, long ldc, int rb, int cb, int wr, int wc, int fr, int fq) {
    const int row0 = rb + wr * 64 + fr, col0 = cb + wc * 32 + 8 * fq;
#pragma unroll
    for (int ai = 0; ai < 2; ++ai)
#pragma unroll
        for (int m = 0; m < 4; ++m) { bf16_t* rowp = O + (size_t)(row0 + ai * HALF + m * 16) * ldc + col0;
#pragma unroll
            for (int bj = 0; bj < 2; ++bj) { const f32x4 v0 = acc[ai][bj][m][0], v1 = acc[ai][bj][m][1];
                u32x4 w; w.x = pk2(v0[0], v0[1]); w.y = pk2(v0[2], v0[3]); w.z = pk2(v1[0], v1[1]); w.w = pk2(v1[2], v1[3]);
                *(u32x4*)(rowp + bj * HALF) = w; } }
}
struct EpiWeff { unsigned char* wbase;
    DI void operator()(const f32x4 (&acc)[2][2][4][2], const Unit& u, int wr, int wc, int fr, int fq) const {
        store_bf16_tile(acc, (bf16_t*)(wbase + (size_t)(u.pm >> 3) * WL + WO_OUT), D, (u.pm & 7) * 256, u.pn * 256, wr, wc, fr, fq); } };
struct EpiProj { bf16_t* P; bf16_t* Vt;
    DI void operator()(const f32x4 (&acc)[2][2][4][2], const Unit& u, int wr, int wc, int fr, int fq) const {
        if (u.pn < 12) store_bf16_tile(acc, P, PWID, u.pm * 256, u.pn * 256, wr, wc, fr, fq);
        else store_bf16_tile(acc, Vt, M, (u.pn - 12) * 256, u.pm * 256, wr, wc, fr, fq);
    } };
struct EpiPool { bf16_t* O;
    DI void operator()(const f32x4 (&acc)[2][2][4][2], const Unit& u, int wr, int wc, int fr, int fq) const { store_bf16_tile(acc, O, D, u.pm * 256, u.pn * 256, wr, wc, fr, fq); } };
struct EpiResid { const float* xin; float* xout; const float* gate;
    DI void operator()(const f32x4 (&acc)[2][2][4][2], const Unit& u, int wr, int wc, int fr, int fq) const {
        const int row0 = u.pm * 256 + wr * 64 + fr, col0 = u.pn * 256 + wc * 32 + 8 * fq; const float* gp = gate + (size_t)(u.pm >> 4) * MODW + col0;
        f32x4 gv[2][2];
#pragma unroll
        for (int bj = 0; bj < 2; ++bj) { gv[bj][0] = *(const f32x4*)(gp + bj * HALF); gv[bj][1] = *(const f32x4*)(gp + bj * HALF + 4); }
#pragma unroll
        for (int ai = 0; ai < 2; ++ai)
#pragma unroll
            for (int m = 0; m < 4; ++m) { const size_t ro = (size_t)(row0 + ai * HALF + m * 16) * D + col0;
#pragma unroll
                for (int bj = 0; bj < 2; ++bj) { const float* xi = xin + ro + bj * HALF; float* xo = xout + ro + bj * HALF;
                    const f32x4 a0 = *(const f32x4*)xi, a1 = *(const f32x4*)(xi + 4);
                    *(f32x4*)xo = a0 + gv[bj][0] * acc[ai][bj][m][0]; *(f32x4*)(xo + 4) = a1 + gv[bj][1] * acc[ai][bj][m][1]; } }
    } };
struct EpiSwiglu { bf16_t* act;
    DI void operator()(const f32x4 (&acc)[2][2][4][2], const Unit& u, int wr, int wc, int fr, int fq) const {
        const int row0 = u.pm * 256 + wr * 64 + fr, col0 = u.pn * 128 + wc * 32 + 8 * fq;
#pragma unroll
        for (int ai = 0; ai < 2; ++ai)
#pragma unroll
            for (int m = 0; m < 4; ++m) { float v[8];
#pragma unroll
                for (int n = 0; n < 2; ++n)
#pragma unroll
                    for (int e = 0; e < 4; ++e) v[4 * n + e] = silu_f(acc[ai][0][m][n][e]) * acc[ai][1][m][n][e];
                u32x4 w; w.x = pk2(v[0], v[1]); w.y = pk2(v[2], v[3]); w.z = pk2(v[4], v[5]); w.w = pk2(v[6], v[7]);
                *(u32x4*)(act + (size_t)(row0 + ai * HALF + m * 16) * DFF + col0) = w; }
    } };
}

DI void tr_item(const float* src, int src_ld, int col0, int lim, int k0, bf16_t* dst, int K, int n0, const float* scale, LAS float* scr, int lane) {
    float v[32];
#pragma unroll
    for (int i = 0; i < 32; ++i) { const int kk = 2 * i + (lane >> 5), cc = col0 + (lane & 31);
        v[i] = (cc < lim) ? __builtin_nontemporal_load(src + (size_t)(k0 + kk) * src_ld + cc) : 0.f; }
#pragma unroll
    for (int i = 0; i < 32; ++i) { const int kk = 2 * i + (lane >> 5); scr[kk * 33 + (lane & 31)] = v[i]; }
    asm volatile("s_waitcnt lgkmcnt(0)" ::: "memory");
    const int c = lane & 7;
#pragma unroll
    for (int j = 0; j < 4; ++j) { const int n = (lane >> 3) + 8 * j; const LAS float* s = scr + (8 * c) * 33 + n; const float sc = scale ? scale[n0 + n] : 1.f;
        u32x4 o; o.x = pk2(s[0 * 33] * sc, s[1 * 33] * sc); o.y = pk2(s[2 * 33] * sc, s[3 * 33] * sc); o.z = pk2(s[4 * 33] * sc, s[5 * 33] * sc); o.w = pk2(s[6 * 33] * sc, s[7 * 33] * sc);
        *(u32x4*)(dst + (size_t)(n0 + n) * K + k0 + 8 * c) = o; }
    asm volatile("s_waitcnt lgkmcnt(0)" ::: "memory");
}

DI void phase0(const int wv, const Params& p, LAS unsigned char* lds) {
    TID_FROM_WV(wv)
    const int lane = tid & 63, wave = tid >> 6, G = GRID, bid = blockIdx.x;
    float* mod = (float*)(p.ws + WS_MOD); float* bias1 = (float*)(p.ws + WS_BIAS1);
    for (int it = bid; it < 196; it += G) {
        __syncthreads();
        if (it < 192) {
            const int l = it / 96, j0 = (it % 96) * 128;
            LAS float* cond = (LAS float*)lds;
            LAS float* red = (LAS float*)(lds + 32768);
            for (int i = tid; i < 4 * D; i += 512) cond[i] = silu_f(p.c[i]);
            __syncthreads();
            float acc[4][2] = {};
            const float* wp = p.w_ada + ((size_t)l * D + wave * 256) * MODW + j0 + 2 * lane;
            for (int k0 = 0; k0 < 256; k0 += 16) { f32x2 wv[16];
#pragma unroll
                for (int u = 0; u < 16; ++u) wv[u] = __builtin_nontemporal_load((const f32x2*)(wp + (size_t)(k0 + u) * MODW));
#pragma unroll
                for (int u = 0; u < 16; ++u)
#pragma unroll
                    for (int b = 0; b < 4; ++b) { const float cb = cond[b * D + wave * 256 + k0 + u]; acc[b][0] += cb * wv[u].x; acc[b][1] += cb * wv[u].y; } }
#pragma unroll
            for (int b = 0; b < 4; ++b) { red[(wave * 4 + b) * 128 + 2 * lane] = acc[b][0]; red[(wave * 4 + b) * 128 + 2 * lane + 1] = acc[b][1]; }
            __syncthreads();
            { const int b = tid >> 7, col = tid & 127; float s = p.b_ada[(size_t)l * MODW + j0 + col];
#pragma unroll
              for (int w = 0; w < 8; ++w) s += red[(w * 4 + b) * 128 + col];
              mod[((size_t)l * 4 + b) * MODW + j0 + col] = s; }
        } else {
            const int l = (it - 192) >> 1, kv = (it - 192) & 1;
            LAS float* red = (LAS float*)lds;
            const int n = tid & 127, kc = tid >> 7;
            const float* pe = p.pe_cmp + ((size_t)(l * 2 + kv)) * 4096 + kc * 1024;
            const float* w1 = p.w_cmp1 + ((size_t)(l * 2 + kv) * 4096 + kc * 1024) * 128 + n;
            float s = 0.f;
#pragma unroll 8
            for (int k = 0; k < 1024; ++k) s += pe[k] * w1[(size_t)k * 128];
            red[kc * 128 + n] = s;
            __syncthreads();
            if (tid < 128) bias1[(l * 2 + kv) * 128 + tid] = red[tid] + red[128 + tid] + red[256 + tid] + red[384 + tid];
        }
    }
    __syncthreads();
    LAS float* scr = (LAS float*)(lds + wave * 8704);
    unsigned* tctr = (unsigned*)(p.ws + WS_BAR) + 3712;
    constexpr int I_IN = (WINR / 32) * (D / 64), I_OUT = (D / 32) * (D / 64), I_GU = (NGU / 32) * (D / 64), I_DN = (D / 32) * (DFF / 64), I_PL = 4 * 8 * 4, I_C1 = 2 * 4 * 64, I_C2 = 2 * 4 * 2;
    constexpr int I_LAYER = I_IN + I_OUT + I_GU + I_DN + I_PL + I_C1 + I_C2;
    volatile LAS int* cslot = (volatile LAS int*)(lds + LDS_BYTES - 256 + 128);
    for (;;) {
    __syncthreads();
    if (tid == 0) *cslot = (int)__hip_atomic_fetch_add(tctr, 64u, __ATOMIC_RELAXED, __HIP_MEMORY_SCOPE_AGENT);
    __syncthreads();
    const int cbase = *cslot;
    if (cbase >= DEPTH * I_LAYER) break;
    for (int it = cbase + wave; it < cbase + 64 && it < DEPTH * I_LAYER; it += 8) {
        const int itr = DEPTH * I_LAYER - 1 - it;
        const int l = itr / I_LAYER; int r = itr % I_LAYER;
        unsigned char* wl = p.ws + WS_W + (size_t)l * WL;
        if (r < I_IN) { const int kb = r / (WINR / 32), nb = r % (WINR / 32); const int n0 = nb * 32;
            int col0 = n0; if (n0 >= 2816 && n0 < 3072) col0 = n0 + 256; else if (n0 >= 3072 && n0 < 3328) col0 = n0 - 256;
            const int lim = (n0 >= 3616) ? 0 : INC;
            tr_item(p.w_in + (size_t)l * D * INC, INC, col0, lim, kb * 64, (bf16_t*)(wl + WO_IN), D, n0, nullptr, scr, lane); continue; } r -= I_IN;
        if (r < I_OUT) { const int kb = r / (D / 32), nb = r % (D / 32);
            tr_item(p.w_out + (size_t)l * D * D, D, nb * 32, D, kb * 64, (bf16_t*)(wl + WO_OUT), D, nb * 32, nullptr, scr, lane); continue; } r -= I_OUT;
        if (r < I_GU) { const int kb = r / (NGU / 32), nb = r % (NGU / 32); const int n0 = nb * 32; const int pn = n0 >> 8, bj = (n0 >> 7) & 1, i0 = n0 & 127;
            tr_item(p.w_gate_up + (size_t)l * D * NGU, NGU, bj * DFF + pn * 128 + i0, NGU, kb * 64, (bf16_t*)(wl + WO_GU), D, n0, nullptr, scr, lane); continue; } r -= I_GU;
        if (r < I_DN) { const int kb = r / (D / 32), nb = r % (D / 32);
            tr_item(p.w_down + (size_t)l * DFF * D, D, nb * 32, D, kb * 64, (bf16_t*)(wl + WO_DOWN), DFF, nb * 32, nullptr, scr, lane); continue; } r -= I_DN;
        if (r < I_PL) { const int g = r >> 5, nb = (r >> 2) & 7, kb = r & 3;
            tr_item(p.w_pool + ((size_t)l * 4 + g) * 65536, 256, nb * 32, 256, kb * 64, (bf16_t*)(wl + WO_POOL) + (size_t)g * 65536, 256, nb * 32, p.pool_scale + (size_t)l * 1024 + g * 256, scr, lane); continue; } r -= I_PL;
        if (r < I_C1) { const int kv = r >> 8, nb = (r >> 6) & 3, kb = r & 63;
            tr_item(p.w_cmp1 + ((size_t)l * 2 + kv) * 4096 * 128, 128, nb * 32, 128, kb * 64, (bf16_t*)(wl + WO_C1) + (size_t)kv * 128 * 4096, 4096, nb * 32, nullptr, scr, lane); continue; } r -= I_C1;
        { const int kv = r >> 3, nb = (r >> 1) & 3, kb = r & 1;
            tr_item(p.w_cmp2 + ((size_t)l * 2 + kv) * 128 * 128, 128, nb * 32, 128, kb * 64, (bf16_t*)(wl + WO_C2) + (size_t)kv * 128 * 128, 128, nb * 32, nullptr, scr, lane); }
    }
    }
}

DI void norm_phase(const int wv, const float* xin, const float* gvec, const float* sh, const float* sc, bf16_t* hout, const bool nt_in) {
    TID_FROM_WV(wv)
    const int lane = tid & 63, wave = tid >> 6, gw = blockIdx.x * 8 + wave;
    static_assert(GRID * 8 * 8 == M, "each wave owns 8 consecutive rows of one batch");
    const int b = gw >> 9, r0 = gw * 8;
    f32x4 gp[8], hh[8];
#pragma unroll
    for (int j = 0; j < 8; ++j) { const int col = 4 * lane + 256 * j;
        gp[j] = *(const f32x4*)(gvec + col) * (*(const f32x4*)(sc + (size_t)b * MODW + col) + 1.f); hh[j] = *(const f32x4*)(sh + (size_t)b * MODW + col); }
    f32x4 v[8], vn[8];
    { const f32x4* xr = (const f32x4*)(xin + (size_t)r0 * D) + lane;
#pragma unroll
      for (int j = 0; j < 8; ++j) v[j] = nt_in ? __builtin_nontemporal_load(xr + 64 * j) : xr[64 * j]; }
#pragma unroll
    for (int k = 0; k < 8; ++k) {
        const int m = r0 + k;
        if (k < 7) { const f32x4* xr = (const f32x4*)(xin + (size_t)(m + 1) * D) + lane;
#pragma unroll
            for (int j = 0; j < 8; ++j) vn[j] = nt_in ? __builtin_nontemporal_load(xr + 64 * j) : xr[64 * j]; }
        float s = 0.f;
#pragma unroll
        for (int j = 0; j < 8; ++j) s += (v[j].x * v[j].x + v[j].y * v[j].y) + (v[j].z * v[j].z + v[j].w * v[j].w);
#pragma unroll
        for (int o = 1; o < 64; o <<= 1) s += __shfl_xor(s, o);
        const float rstd = rsqrtf(s * (1.f / D) + 1e-6f);
        u32x2* o8 = (u32x2*)(hout + (size_t)m * D) + lane;
#pragma unroll
        for (int j = 0; j < 8; ++j) { const f32x4 y = v[j] * rstd * gp[j] + hh[j];
            u32x2 w; w.x = pk2(y.x, y.y); w.y = pk2(y.z, y.w); o8[64 * j] = w; }
#pragma unroll
        for (int j = 0; j < 8; ++j) v[j] = vn[j];
    }
}

template <int W>
DI void pool_item(const bf16_t* P, bf16_t* pooled, const size_t m0, const int c8) {
    const int t0 = (int)(m0 & (size_t)(T - 1));
    u32x4 raw[W + 3];
#pragma unroll
    for (int k = 0; k < W + 3; ++k) { const int dt = k - (W - 1);
        raw[k] = (t0 + dt >= 0) ? *(const u32x4*)(P + (size_t)((long)m0 + dt) * PWID + c8) : (u32x4){0u, 0u, 0u, 0u}; }
    float s[8] = {0.f, 0.f, 0.f, 0.f, 0.f, 0.f, 0.f, 0.f};
#pragma unroll
    for (int k = 0; k < W; ++k) { s[0] += bflo(raw[k].x); s[1] += bfhi(raw[k].x); s[2] += bflo(raw[k].y); s[3] += bfhi(raw[k].y); s[4] += bflo(raw[k].z); s[5] += bfhi(raw[k].z); s[6] += bflo(raw[k].w); s[7] += bfhi(raw[k].w); }
#pragma unroll
    for (int j = 0; j < 4; ++j) {
        const int cnt = (t0 + j + 1 < W) ? t0 + j + 1 : W; const float inv = 1.f / (float)cnt;
        const u32x4 c = raw[j + W - 1];
        u32x4 o; o.x = pk2(s[0] * inv - bflo(c.x), s[1] * inv - bfhi(c.x)); o.y = pk2(s[2] * inv - bflo(c.y), s[3] * inv - bfhi(c.y));
        o.z = pk2(s[4] * inv - bflo(c.z), s[5] * inv - bfhi(c.z)); o.w = pk2(s[6] * inv - bflo(c.w), s[7] * inv - bfhi(c.w));
        *(u32x4*)(pooled + (m0 + j) * 1024 + c8) = o;
        if (j < 3) { const u32x4 a = raw[j + W], d = raw[j];
            s[0] += bflo(a.x) - bflo(d.x); s[1] += bfhi(a.x) - bfhi(d.x); s[2] += bflo(a.y) - bflo(d.y); s[3] += bfhi(a.y) - bfhi(d.y);
            s[4] += bflo(a.z) - bflo(d.z); s[5] += bfhi(a.z) - bfhi(d.z); s[6] += bflo(a.w) - bflo(d.w); s[7] += bfhi(a.w) - bfhi(d.w); }
    }
}

DI void prep_phase(const int wv, const Params& p, int l, LAS unsigned char* lds) {
    TID_FROM_WV(wv)
    const int lane = tid & 63, wave = tid >> 6, G = GRID, bid = blockIdx.x;
    bf16_t* P = (bf16_t*)(p.ws + WS_P);
    {
        const unsigned char* wl = p.ws + WS_W + (size_t)l * WL;
        const float* bias1 = (const float*)(p.ws + WS_BIAS1) + l * 256;
        bf16_t* kcmp = (bf16_t*)(p.ws + WS_KCMP); bf16_t* vcmp = (bf16_t*)(p.ws + WS_VCMP);
        LAS bf16_t* Hs = (LAS bf16_t*)lds;
        LAS float* red = (LAS float*)(lds + 8192);
        LAS float* part = (LAS float*)(lds + 16384);
        const int r16 = lane & 15, kq = lane >> 4;
        for (int u = bid; u < 256; u += G) {
            const int ch = u & 15, g = (u >> 4) & 1, b = (u >> 5) & 3, kv = u >> 7, c0 = ch * 16;
            const bf16_t* W1t = (const bf16_t*)(wl + WO_C1) + (size_t)kv * 128 * 4096;
            const bf16_t* W2t = (const bf16_t*)(wl + WO_C2) + (size_t)kv * 128 * 128;
            const bf16_t* Arow = P + ((size_t)b * T + 16 * (c0 + r16)) * PWID + (kv ? PC_VC : PC_KC) + g * 128 + 8 * kq;
            const bf16_t* Brow = W1t + (size_t)r16 * 4096 + 8 * kq;
            f32x4 acc[8];
#pragma unroll
            for (int nt = 0; nt < 8; ++nt) acc[nt] = (f32x4){0.f, 0.f, 0.f, 0.f};
#pragma unroll 2
            for (int kk = 0; kk < 16; ++kk) { const int ks = 16 * wave + kk;
                const bf16x8 a = *(const bf16x8*)(Arow + (size_t)(ks >> 2) * PWID + (ks & 3) * 32);
#pragma unroll
                for (int nt = 0; nt < 8; ++nt) { const bf16x8 bb = *(const bf16x8*)(Brow + (size_t)nt * 16 * 4096 + ks * 32);
                    acc[nt] = __builtin_amdgcn_mfma_f32_16x16x32_bf16(a, bb, acc[nt], 0, 0, 0); }
            }
            __syncthreads();
#pragma unroll
            for (int nt = 0; nt < 8; ++nt)
#pragma unroll
                for (int i = 0; i < 4; ++i) part[(wave * 16 + 4 * kq + i) * 128 + 16 * nt + r16] = acc[nt][i];
            __syncthreads();
            { const int row = tid >> 5, n4 = (tid & 31) * 4; f32x4 s = *(const f32x4*)(bias1 + kv * 128 + n4);
#pragma unroll
              for (int w = 0; w < 8; ++w) s += *(const LAS f32x4*)(part + (w * 16 + row) * 128 + n4);
              u32x2 hv; hv.x = pk2(silu_f(s.x), silu_f(s.y)); hv.y = pk2(silu_f(s.z), silu_f(s.w));
              *(LAS u32x2*)(Hs + row * 136 + n4) = hv; }
            __syncthreads();
            f32x4 acc2 = {0.f, 0.f, 0.f, 0.f};
#pragma unroll
            for (int ks = 0; ks < 4; ++ks) {
                const bf16x8 a = *(const LAS bf16x8*)(Hs + r16 * 136 + ks * 32 + 8 * kq);
                const bf16x8 bb = *(const bf16x8*)(W2t + (size_t)(16 * wave + r16) * 128 + ks * 32 + 8 * kq);
                acc2 = __builtin_amdgcn_mfma_f32_16x16x32_bf16(a, bb, acc2, 0, 0, 0);
            }
            const int n = 16 * wave + r16;
            if (kv == 0) {
                float ss[4];
#pragma unroll
                for (int i = 0; i < 4; ++i) { float s = acc2[i] * acc2[i]; s += __shfl_xor(s, 1); s += __shfl_xor(s, 2); s += __shfl_xor(s, 4); s += __shfl_xor(s, 8); ss[i] = s; }
                if (r16 == 0) {
#pragma unroll
                    for (int i = 0; i < 4; ++i) red[wave * 16 + 4 * kq + i] = ss[i]; }
                __syncthreads();
                const float gn = p.k_gain[(l * 3 + 0) * 128 + n];
#pragma unroll
                for (int i = 0; i < 4; ++i) { const int row = 4 * kq + i; float s = 0.f;
#pragma unroll
                    for (int w = 0; w < 8; ++w) s += red[w * 16 + row];
                    const float rstd = rsqrtf(s * (1.f / 128.f) + 1e-6f); const int c = c0 + row;
                    const float v = (c < 255) ? acc2[i] * rstd * gn : 0.f;
                    kcmp[(((size_t)b * 2 + g) * 256 + c) * 128 + n] = (bf16_t)(pk2(v, 0.f) & 0xffffu); }
            } else {
                float v[4];
#pragma unroll
                for (int i = 0; i < 4; ++i) v[i] = (c0 + 4 * kq + i < 255) ? acc2[i] : 0.f;
                u32x2 w; w.x = pk2(v[0], v[1]); w.y = pk2(v[2], v[3]);
                *(u32x2*)(vcmp + (((size_t)b * 2 + g) * 128 + n) * 256 + c0 + 4 * kq) = w;
            }
        }
    }
    {
        static_assert(GRID * 8 * 8 == M, "each wave owns 8 consecutive tokens");
        const int sub = lane & 15, g4 = lane >> 4, gw = bid * 8 + wave;
        float gq[8], gk[8];
        { const float* gqp = p.q_gain + l * 128 + 8 * sub; const float* gkp = p.k_gain + (l * 3 + ((g4 < 2) ? 1 : 2)) * 128 + 8 * sub;
          const f32x4 a0 = *(const f32x4*)gqp, a1 = *(const f32x4*)(gqp + 4), b0 = *(const f32x4*)gkp, b1 = *(const f32x4*)(gkp + 4);
          const float qs = 0.08838834764831845f * 1.44269504f;
          gq[0] = a0.x * qs; gq[1] = a0.y * qs; gq[2] = a0.z * qs; gq[3] = a0.w * qs; gq[4] = a1.x * qs; gq[5] = a1.y * qs; gq[6] = a1.z * qs; gq[7] = a1.w * qs;
          gk[0] = b0.x; gk[1] = b0.y; gk[2] = b0.z; gk[3] = b0.w; gk[4] = b1.x; gk[5] = b1.y; gk[6] = b1.z; gk[7] = b1.w; }
        const int colk = (g4 < 2) ? (PC_KS + 128 * g4) : (PC_KW + 128 * (g4 - 2));
        bf16_t* Pw = P + (size_t)gw * 8 * PWID + 8 * sub;
#pragma unroll
        for (int k = 0; k < 3; ++k) {
            const int col = (k < 2) ? (PC_Q + 128 * (g4 + 4 * k)) : colk;
#pragma unroll
            for (int tq = 0; tq < 2; ++tq) {
                u32x4 raw[4];
#pragma unroll
                for (int j = 0; j < 4; ++j) raw[j] = *(const u32x4*)(Pw + (size_t)(tq * 4 + j) * PWID + col);
#pragma unroll
                for (int j = 0; j < 4; ++j) {
                    const u32x4 rw = raw[j];
                    float f[8] = {bflo(rw.x), bfhi(rw.x), bflo(rw.y), bfhi(rw.y), bflo(rw.z), bfhi(rw.z), bflo(rw.w), bfhi(rw.w)};
                    float s = 0.f;
#pragma unroll
                    for (int e = 0; e < 8; ++e) s += f[e] * f[e];
                    s += __shfl_xor(s, 1); s += __shfl_xor(s, 2); s += __shfl_xor(s, 4); s += __shfl_xor(s, 8);
                    const float rstd = rsqrtf(s * (1.f / 128.f) + 1e-6f);
                    u32x4 o;
                    if (k < 2) { o.x = pk2(f[0] * rstd * gq[0], f[1] * rstd * gq[1]); o.y = pk2(f[2] * rstd * gq[2], f[3] * rstd * gq[3]); o.z = pk2(f[4] * rstd * gq[4], f[5] * rstd * gq[5]); o.w = pk2(f[6] * rstd * gq[6], f[7] * rstd * gq[7]); }
                    else { o.x = pk2(f[0] * rstd * gk[0], f[1] * rstd * gk[1]); o.y = pk2(f[2] * rstd * gk[2], f[3] * rstd * gk[3]); o.z = pk2(f[4] * rstd * gk[4], f[5] * rstd * gk[5]); o.w = pk2(f[6] * rstd * gk[6], f[7] * rstd * gk[7]); }
                    *(u32x4*)(Pw + (size_t)(tq * 4 + j) * PWID + col) = o;
                }
            }
        }
    }
    {
        bf16_t* pooled = (bf16_t*)(p.ws + WS_POOLED);
        const int gw = bid * 8 + wave, NGW = G * 8, cc = lane & 31, half = lane >> 5;
        for (int wi = gw; wi < 4 * (M / 8); wi += NGW) {
            const int gi = (wi + (wi >> 11)) & 3, tq = wi >> 2; const size_t m0 = (size_t)tq * 8 + 4 * half; const int c8 = gi * 256 + cc * 8;
            if (gi == 0) pool_item<2>(P, pooled, m0, c8); else if (gi == 1) pool_item<4>(P, pooled, m0, c8); else if (gi == 2) pool_item<8>(P, pooled, m0, c8); else pool_item<16>(P, pooled, m0, c8);
        }
    }
}

namespace att {
constexpr int KST = 272, VST = 136;
constexpr int K_OFF = 0, V_OFF = 64 * KST, KV_BYTES = 64 * KST + 128 * VST, IMP_OFF = 2 * KV_BYTES, SEL_OFF = IMP_OFF + 64 * 64 * 4, UNI_OFF = SEL_OFF + 64 * 8, OUT_OFF = UNI_OFF + 64;
#define MFMA32(a, b, c) __builtin_amdgcn_mfma_f32_32x32x16_bf16((a), (b), (c), 0, 0, 0)

template <int MODE>
DI void branch(const int wv, LAS unsigned char* lds, const bf16x8 (&qf)[8], const char* kbase, const long ldk, const char* vbase, const long ldv,
               unsigned long long tiles, const unsigned long long wsel, const unsigned long long wall, const int qt, const int t_tok, const float sc_l2, const float sl_l2, const float m_fix,
               const unsigned long long selm, const float p_scale, float& l_run, f32x16 (&O)[4], LAS float* imp_row) {
    TID_FROM_WV(wv)
    const int lane = tid & 63, rr = lane & 31, h = lane >> 5;
    constexpr bool CMP = (MODE < 2);
    constexpr int KS = CMP ? 16 : 1;
    u32x4 kr[2], vr[2];
    float carry = 0.f;
#define ATT_LOAD(j) do { _Pragma("unroll") for (int _i = 0; _i < 2; ++_i) { const int _c = tid + 512 * _i; \
        kr[_i] = *(const u32x4*)(kbase + (size_t)(64 * (j) + (_c >> 4)) * ldk + (_c & 15) * 16); \
        if (MODE != 0) vr[_i] = *(const u32x4*)(vbase + (size_t)(_c >> 3) * ldv + (size_t)(j) * 128 + (_c & 7) * 16); } } while (0)
#define ATT_STORE(LB) do { _Pragma("unroll") for (int _i = 0; _i < 2; ++_i) { const int _c = tid + 512 * _i; \
        *(LAS u32x4*)((LB) + K_OFF + (_c >> 4) * KST + (_c & 15) * 16) = kr[_i]; \
        if (MODE != 0) { LAS u32x2* _d = (LAS u32x2*)((LB) + V_OFF + (_c >> 3) * VST + (_c & 7) * 16); _d[0] = (u32x2){vr[_i].x, vr[_i].y}; _d[1] = (u32x2){vr[_i].z, vr[_i].w}; } } } while (0)
    int j = __builtin_ctzll(tiles); tiles &= tiles - 1;
    LAS unsigned char* const lds0 = lds;
    ATT_LOAD(j); ATT_STORE(lds0);
    __syncthreads();
    int buf = 0;
    unsigned touch = 0u;
    for (;;) {
        LAS unsigned char* const lds = lds0 + buf * KV_BYTES;
        const bool has_next = tiles != 0ull;
        int jn = j;
        unsigned touch_new = 0u;
        if (has_next) { jn = __builtin_ctzll(tiles); tiles &= tiles - 1; ATT_LOAD(jn);
            if (tiles != 0ull) {
                const int j2 = __builtin_ctzll(tiles);
                if (tid < 128) touch_new = *(const volatile unsigned*)(kbase + (size_t)(64 * j2 + (tid >> 1)) * ldk + (tid & 1) * 128);
                else if (MODE != 0 && tid < 256) touch_new = *(const volatile unsigned*)(vbase + (size_t)(tid - 128) * ldv + (size_t)j2 * 128);
            } }
        if (MODE != 2 || ((wsel >> j) & 1ull)) {
        const int dbase = CMP ? (t_tok - 31 - 16 * (64 * j + 4 * h)) : (t_tok - 64 * j - 4 * h);
        const bool selbit = (MODE == 2) ? (((selm >> j) & 1ull) != 0ull) : true;
        const float b0 = selbit ? (-sl_l2 * (float)dbase - m_fix) : -1e30f;
        f32x16 X0, X1;
#pragma unroll
        for (int i = 0; i < 16; ++i) { X0[i] = __builtin_fmaf(sl_l2, (float)(KS * ((i & 3) + 8 * (i >> 2))), b0); X1[i] = __builtin_fmaf(sl_l2, (float)(KS * (32 + (i & 3) + 8 * (i >> 2))), b0); }
#pragma unroll
        for (int ks = 0; ks < 8; ++ks) {
            const bf16x8 k0 = *(const LAS bf16x8*)(lds + K_OFF + rr * KST + (16 * ks + 8 * h) * 2);
            X0 = MFMA32(k0, qf[ks], X0);
        }
#pragma unroll
        for (int ks = 0; ks < 8; ++ks) {
            const bf16x8 k1 = *(const LAS bf16x8*)(lds + K_OFF + (32 + rr) * KST + (16 * ks + 8 * h) * 2);
            X1 = MFMA32(k1, qf[ks], X1);
        }
        bool interior = false;
        if (MODE == 2) interior = (j < qt);
        if (MODE == 3) interior = (j < qt) && (j > qt - 8);
        float rs = 0.f;
#define ATT_SOFTMAX(X, SUB) do { \
        if (interior) { _Pragma("unroll") for (int i = 0; i < 16; ++i) { const float pv_ = fast_exp2(X[i]); X[i] = pv_; rs += pv_; } } \
        else { _Pragma("unroll") for (int i = 0; i < 16; ++i) { const int kc_ = KS * (32 * (SUB) + (i & 3) + 8 * (i >> 2)); \
            bool v_ = (dbase >= kc_) && selbit; if (MODE == 3) v_ = v_ && (dbase - kc_ < 512); \
            float pv_ = fast_exp2(X[i]); pv_ = v_ ? pv_ : 0.f; X[i] = pv_; rs += pv_; } } } while (0)
#define ATT_PV(X, SUB) do { _Pragma("unroll") for (int s = 0; s < 2; ++s) { \
        u32x4 pp; pp.x = pk2(X[8 * s], X[8 * s + 1]); pp.y = pk2(X[8 * s + 2], X[8 * s + 3]); pp.z = pk2(X[8 * s + 4], X[8 * s + 5]); pp.w = pk2(X[8 * s + 6], X[8 * s + 7]); \
        const bf16x8 pb = __builtin_bit_cast(bf16x8, pp); \
        _Pragma("unroll") for (int dt = 0; dt < 4; ++dt) { \
            const LAS unsigned char* va = lds + V_OFF + (32 * dt + rr) * VST + (32 * (SUB) + 16 * s + 4 * h) * 2; \
            const s16x4 lo = *(const LAS s16x4*)va, hi = *(const LAS s16x4*)(va + 16); \
            const bf16x8 vf = __builtin_shufflevector(lo, hi, 0, 1, 2, 3, 4, 5, 6, 7); \
            O[dt] = MFMA32(vf, pb, O[dt]); } } } while (0)
#define ATT_VLOAD(DST, SUB, S) do { _Pragma("unroll") for (int dt = 0; dt < 4; ++dt) { \
            const LAS unsigned char* va = lds + V_OFF + (32 * dt + rr) * VST + (32 * (SUB) + 16 * (S) + 4 * h) * 2; \
            const s16x4 lo = *(const LAS s16x4*)va, hi = *(const LAS s16x4*)(va + 16); \
            DST[dt] = __builtin_shufflevector(lo, hi, 0, 1, 2, 3, 4, 5, 6, 7); } } while (0)
#define ATT_PVS(X, S, VF) do { u32x4 pp; pp.x = pk2(X[8 * (S)], X[8 * (S) + 1]); pp.y = pk2(X[8 * (S) + 2], X[8 * (S) + 3]); pp.z = pk2(X[8 * (S) + 4], X[8 * (S) + 5]); pp.w = pk2(X[8 * (S) + 6], X[8 * (S) + 7]); \
        const bf16x8 pb = __builtin_bit_cast(bf16x8, pp); \
        _Pragma("unroll") for (int dt = 0; dt < 4; ++dt) O[dt] = MFMA32(VF[dt], pb, O[dt]); } while (0)
        ATT_SOFTMAX(X0, 0);
        if (MODE >= 2) ATT_PV(X0, 0);
        ATT_SOFTMAX(X1, 1);
        if (MODE >= 2) ATT_PV(X1, 1);
        if (MODE != 1) l_run += rs;
        else {
#pragma unroll
            for (int i = 0; i < 16; ++i) { X0[i] *= p_scale; X1[i] *= p_scale; }
#pragma unroll
            for (int sub = 0; sub < 2; ++sub) {
                float A[4], L[4], tL[4], own[4];
#pragma unroll
                for (int gq = 0; gq < 4; ++gq) { const float a0 = sub ? X1[4 * gq] : X0[4 * gq], a1 = sub ? X1[4 * gq + 1] : X0[4 * gq + 1], a2 = sub ? X1[4 * gq + 2] : X0[4 * gq + 2], a3 = sub ? X1[4 * gq + 3] : X0[4 * gq + 3];
                    A[gq] = (a0 + a1) + (a2 + a3); L[gq] = a3; }
#pragma unroll
                for (int gq = 0; gq < 4; ++gq) tL[gq] = __shfl_xor(L[gq], 32);
                own[0] = A[0] + (h ? tL[0] : carry);
#pragma unroll
                for (int gq = 1; gq < 4; ++gq) own[gq] = A[gq] + (h ? tL[gq] : tL[gq - 1]);
                carry = tL[3];
#pragma unroll
                for (int gq = 0; gq < 4; ++gq) { float v = own[gq]; v += __shfl_xor(v, 1); v += __shfl_xor(v, 2); own[gq] = v; }
                if ((lane & 3) == 0) {
#pragma unroll
                    for (int gq = 0; gq < 4; ++gq) imp_row[16 * j + 8 * sub + 2 * gq + h] = own[gq]; }
            }
            ATT_PV(X0, 0); ATT_PV(X1, 1);
        }
#undef ATT_SOFTMAX
#undef ATT_PV
#undef ATT_VLOAD
#undef ATT_PVS
        }
        asm volatile("" :: "v"(touch));
        touch = touch_new;
        if (!has_next) break;
        ATT_STORE(lds0 + (buf ^ 1) * KV_BYTES);
        __syncthreads();
        buf ^= 1; j = jn;
    }
    asm volatile("" :: "v"(touch));
    __syncthreads();
#undef ATT_LOAD
#undef ATT_STORE
}

DI float wave_max(float v) {
#pragma unroll
    for (int o = 1; o < 64; o <<= 1) v = fmaxf(v, __shfl_xor(v, o));
    return v;
}
DI void unit(const int wv, const Params& p, int l, int b, int g, int qt, LAS unsigned char* lds) {
    TID_FROM_WV(wv)
    const int lane = tid & 63, wave = tid >> 6, rr = lane & 31, h = lane >> 5, r = lane & 3, tl = rr >> 2;
    const bf16_t* P = (const bf16_t*)(p.ws + WS_P); const bf16_t* Vt = (const bf16_t*)(p.ws + WS_VT);
    const int tok_l = 8 * wave + tl, t_tok = 64 * qt + tok_l, head = g * 4 + r; const unsigned m = (unsigned)(b * T + t_tok);
    LAS float* imp = (LAS float*)(lds + IMP_OFF); LAS unsigned long long* selw = (LAS unsigned long long*)(lds + SEL_OFF); LAS unsigned long long* uniw = (LAS unsigned long long*)(lds + UNI_OFF);
    bf16x8 qf[8];
    { const bf16_t* qp = P + (size_t)(m * (unsigned)PWID + PC_Q + head * 128 + 8 * h);
#pragma unroll
      for (int ks = 0; ks < 8; ++ks) qf[ks] = *(const bf16x8*)(qp + 16 * ks); }
    const float sc_l2 = 0.08838834764831845f * 1.44269504f;
    const float sl_l2 = __builtin_amdgcn_exp2f(-(float)(head + 1)) * 1.44269504f;
    float qn;
    { float s = 0.f;
#pragma unroll
      for (int ks = 0; ks < 8; ++ks)
#pragma unroll
          for (int e = 0; e < 8; ++e) { const float f = bf2f((unsigned short)qf[ks][e]); s += f * f; }
      s += __shfl_xor(s, 32); qn = sqrtf(s) * (11.313708499f * 1.02f); }
#define ATT_GK(k) wave_max(fmaxf(fabsf(p.k_gain[(l * 3 + (k)) * 128 + lane]), fabsf(p.k_gain[(l * 3 + (k)) * 128 + lane + 64])))
#define ATT_GL(k) bf2f(Vt[(unsigned)(VR_GL + head * 3 + (k)) * (unsigned)M + m])
    for (int i = tid; i < 64 * 64; i += 512) imp[i] = 0.f;
    __syncthreads();
    f32x16 O[4]; LAS unsigned* outp = (LAS unsigned*)(lds + OUT_OFF) + wave * 2048 + lane;
    const char* kc_base = (const char*)(p.ws + WS_KCMP) + ((size_t)b * 2 + g) * 256 * 256;
    const char* vc_base = (const char*)(p.ws + WS_VCMP) + ((size_t)b * 2 + g) * 128 * 512;
    const int nct = (4 * qt + 2) / 64 + 1;
    const unsigned long long ctiles = (1ull << nct) - 1ull;
    float l_c = 0.f;
    branch<0>(wv, lds, qf, kc_base, 256, vc_base, 512, ctiles, ~0ull, 0ull, qt, t_tok, sc_l2, sl_l2, qn * ATT_GK(0), 0ull, 0.f, l_c, O, imp + tok_l * 64);
    { const float lt = l_c + __shfl_xor(l_c, 32); l_c = (lt > 0.f) ? 1.f / lt : 0.f; }
#pragma unroll
    for (int dt = 0; dt < 4; ++dt)
#pragma unroll
        for (int i = 0; i < 16; ++i) O[dt][i] = 0.f;
    { float dummy = 0.f;
      branch<1>(wv, lds, qf, kc_base, 256, vc_base, 512, ctiles, ~0ull, 0ull, qt, t_tok, sc_l2, sl_l2, qn * ATT_GK(0), 0ull, l_c, dummy, O, imp + tok_l * 64); }
    { const float gt = sigmoid_f(ATT_GL(0));
#pragma unroll
      for (int dt = 0; dt < 4; ++dt)
#pragma unroll
          for (int i = 0; i < 8; ++i) outp[(dt * 8 + i) * 64] = pk2(gt * O[dt][2 * i], gt * O[dt][2 * i + 1]); }
    __syncthreads();
    unsigned long long wuni = 0ull, wall = ~0ull;
    {
        for (int t8 = 0; t8 < 8; ++t8) {
            const float v = imp[(8 * wave + t8) * 64 + lane];
            const bool valid = lane <= qt, forced = (lane == 0) || (lane == qt) || (lane == qt - 1);
            const float sc = valid ? (v + (forced ? 1000.f : 0.f)) : -1e30f;
            int rank = 0;
#pragma unroll 4
            for (int jj = 0; jj <= qt; ++jj) {        const float sj = __builtin_bit_cast(float, __builtin_amdgcn_readlane(__builtin_bit_cast(int, sc), jj)); rank += ((sj > sc) || (sj == sc && jj < lane)) ? 1 : 0; }
            const unsigned long long sel = __ballot((rank < 16) && valid);
            if (lane == 0) selw[8 * wave + t8] = sel;
            wuni |= sel; wall &= sel;
        }
        if (lane == 0) uniw[wave] = wuni;
    }
    __syncthreads();
    unsigned long long uni = 0ull;
#pragma unroll
    for (int w = 0; w < 8; ++w) uni |= uniw[w];
    const unsigned long long selm = selw[tok_l];
    {
        const char* kb = (const char*)(P + (size_t)b * T * PWID + PC_KS + g * 128);
        const char* vb = (const char*)(Vt + (size_t)(VR_VS + g * 128) * M + (size_t)b * T);
        float lr = 0.f;
#pragma unroll
        for (int dt = 0; dt < 4; ++dt)
#pragma unroll
            for (int i = 0; i < 16; ++i) O[dt][i] = 0.f;
        branch<2>(wv, lds, qf, kb, (long)PWID * 2, vb, (long)M * 2, uni, wuni, wall, qt, t_tok, sc_l2, sl_l2, qn * ATT_GK(1), selm, 0.f, lr, O, nullptr);
        const float lt = lr + __shfl_xor(lr, 32); const float gt = sigmoid_f(ATT_GL(1)) * ((lt > 0.f) ? 1.f / lt : 0.f);
#pragma unroll
        for (int dt = 0; dt < 4; ++dt)
#pragma unroll
            for (int i = 0; i < 8; ++i) { const unsigned pv = outp[(dt * 8 + i) * 64]; outp[(dt * 8 + i) * 64] = pk2(bflo(pv) + gt * O[dt][2 * i], bfhi(pv) + gt * O[dt][2 * i + 1]); }
    }
    {
        const char* kb = (const char*)(P + (size_t)b * T * PWID + PC_KW + g * 128);
        const char* vb = (const char*)(Vt + (size_t)(VR_VW + g * 128) * M + (size_t)b * T);
        const int j0 = (qt >= 8) ? qt - 8 : 0;
        const unsigned long long wt = ((qt == 63) ? ~0ull : ((1ull << (qt + 1)) - 1ull)) & ~((1ull << j0) - 1ull);
        float lr = 0.f;
#pragma unroll
        for (int dt = 0; dt < 4; ++dt)
#pragma unroll
            for (int i = 0; i < 16; ++i) O[dt][i] = 0.f;
        branch<3>(wv, lds, qf, kb, (long)PWID * 2, vb, (long)M * 2, wt, ~0ull, 0ull, qt, t_tok, sc_l2, sl_l2, qn * ATT_GK(2), 0ull, 0.f, lr, O, nullptr);
        const float lt = lr + __shfl_xor(lr, 32); const float gt = sigmoid_f(ATT_GL(2)) * ((lt > 0.f) ? 1.f / lt : 0.f);
#pragma unroll
        for (int dt = 0; dt < 4; ++dt)
#pragma unroll
            for (int i = 0; i < 8; ++i) { const unsigned pv = outp[(dt * 8 + i) * 64]; outp[(dt * 8 + i) * 64] = pk2(bflo(pv) + gt * O[dt][2 * i], bfhi(pv) + gt * O[dt][2 * i + 1]); }
    }
    bf16_t* op = (bf16_t*)(p.ws + WS_CONCAT) + (size_t)(m * (unsigned)D + 1024 + head * 128 + 4 * h);
#pragma unroll
    for (int dt = 0; dt < 4; ++dt)
#pragma unroll
        for (int gq = 0; gq < 4; ++gq) { u32x2 w; w.x = outp[(dt * 8 + 2 * gq) * 64]; w.y = outp[(dt * 8 + 2 * gq + 1) * 64];
            *(u32x2*)(op + 32 * dt + 8 * gq) = w; }
}
static_assert(OUT_OFF + 8 * 2048 * 4 <= LDS_BYTES - 256, "attention LDS map");
}


#define XB_TMO      128
#define XB_XCNT(j)  (256  + 64 * (j))
#define XB_XSUB(j)  (1280 + 64 * (j))
#define XB_XGEN(j)  (2304 + 64 * (j))
#define XB_TOP      3328
#define XB_TOPGEN   3392
#define XCD_BAR_WORDS 3456
#define XB_SPIN_CAP (1u << 18)
DI unsigned xb_ld(unsigned* p)              { return __hip_atomic_load(p, __ATOMIC_RELAXED, __HIP_MEMORY_SCOPE_AGENT); }
DI unsigned xb_add(unsigned* p, unsigned v) { return __hip_atomic_fetch_add(p, v, __ATOMIC_RELAXED, __HIP_MEMORY_SCOPE_AGENT); }
DI unsigned xb_xcc_id() { return (unsigned)__builtin_amdgcn_s_getreg((3 << 11) | 20) & 0xFu; }
#define XB_SPIN(cond, bar) do { unsigned _sp = 0; while (cond) { __builtin_amdgcn_s_sleep(1); \
    if ((++_sp & 255u) == 0u) { if (xb_ld(&(bar)[XB_TMO])) break; if (_sp > XB_SPIN_CAP) { atomicAdd(&(bar)[XB_TMO], 1u); break; } } } } while (0)
struct XcdBarrier { unsigned* bar; unsigned x; volatile LAS unsigned* st; };
DI XcdBarrier xcd_barrier_post(const int wv, unsigned* bar, volatile LAS unsigned* st) {
    XcdBarrier b; b.bar = bar; b.x = xb_xcc_id(); b.st = st;
    if (wv == 0 && lane_id_() == 0) (void)xb_add(&bar[XB_XCNT(b.x)], 1u);
    return b;
}
DI void xcd_barrier_complete(unsigned* bar, unsigned x, unsigned& nloc, unsigned& nx) {
    const unsigned G = GRID;
    unsigned sum, cnt, mine, sp = 0u;
    for (;;) {
        sum = 0u; cnt = 0u; mine = 0u;
#pragma unroll
        for (unsigned j = 0; j < 16; ++j) { const unsigned c = xb_ld(&bar[XB_XCNT(j)]); sum += c; cnt += (c > 0u) ? 1u : 0u; }
        if (sum == G) { mine = xb_ld(&bar[XB_XCNT(x)]); break; }
        __builtin_amdgcn_s_sleep(1);
        if ((++sp & 255u) == 0u) { if (xb_ld(&bar[XB_TMO])) break; if (sp > XB_SPIN_CAP) { atomicAdd(&bar[XB_TMO], 1u); break; } }
    }
    nloc = mine > 0u ? mine : 1u; nx = cnt > 0u ? cnt : 1u;
}
DI void xcd_barrier(const int wv, const XcdBarrier& b) {
    asm volatile("s_waitcnt vmcnt(0)" ::: "memory");
    __syncthreads();
    if (wv == 0 && lane_id_() == 0) {
        unsigned* bar = b.bar;
        __builtin_amdgcn_s_waitcnt(0);
        unsigned nloc = b.st[0], nx = b.st[1];
        if (nloc == 0u) { xcd_barrier_complete(bar, b.x, nloc, nx); b.st[0] = nloc; b.st[1] = nx; }
        const unsigned old = xb_add(&bar[XB_XSUB(b.x)], 1u);
        const unsigned gen = old / nloc;
        if (old + 1u == (gen + 1u) * nloc) {
            __builtin_amdgcn_fence(__ATOMIC_RELEASE, "agent");
            asm volatile("s_waitcnt vmcnt(0)" ::: "memory");
            const unsigned og = xb_add(&bar[XB_TOP], 1u);
            const unsigned tg = og / nx;
            if (og + 1u == (tg + 1u) * nx) xb_add(&bar[XB_TOPGEN], 1u);
            else XB_SPIN(xb_ld(&bar[XB_TOPGEN]) == tg, bar);
            __builtin_amdgcn_fence(__ATOMIC_ACQUIRE, "agent");
            xb_add(&bar[XB_XGEN(b.x)], 1u);
            asm volatile("s_waitcnt vmcnt(0)" ::: "memory");
        } else {
            XB_SPIN(xb_ld(&bar[XB_XGEN(b.x)]) == gen, bar);
            __builtin_amdgcn_fence(__ATOMIC_ACQUIRE, "agent");
            asm volatile("s_waitcnt vmcnt(0)" ::: "memory");
        }
    }
    __syncthreads();
}

DI unsigned char* opaque_ptr(unsigned char* q) { asm volatile("" : "+s"(q)); return q; }
__global__ void __launch_bounds__(512, 2) mega(Params p) {
    extern __shared__ __attribute__((aligned(16))) unsigned char lds_raw[];
    LAS unsigned char* lds = (LAS unsigned char*)lds_raw;
    cg::grid_group grid = cg::this_grid();
    const int wv = __builtin_amdgcn_readfirstlane((int)threadIdx.x >> 6);
    const int G = GRID, bid = blockIdx.x;
#define IN(k) (p.ph_lo <= (k) && (k) < p.ph_hi)
#define SEAM(k) do { if (IN(k) && IN((k) + 1)) xcd_barrier(wv, bar); } while (0)
    volatile LAS unsigned* MISC = (volatile LAS unsigned*)(lds + LDS_BYTES - 256);
    if (wv == 0 && lane_id_() < 16) MISC[lane_id_()] = 0u;
    __syncthreads();
    XcdBarrier bar; bar.bar = (unsigned*)(p.ws + WS_BAR); bar.x = 0; bar.st = MISC;
    if (p.ph_hi < 0) grid.sync();
    if (p.ph_hi - p.ph_lo > 1) bar = xcd_barrier_post(wv, (unsigned*)(p.ws + WS_BAR), MISC);
    if (IN(0)) phase0(wv, p, lds);
    SEAM(0);
    for (int l = 0; l < DEPTH; ++l) {
        const int pb = 1 + 8 * l;
#define WL_(wq) ((wq) + WS_W + (size_t)l * WL)
#define MODL_(wq) ((const float*)((wq) + WS_MOD) + (size_t)l * 4 * MODW)
        if (IN(pb + 0)) { unsigned char* const wq = opaque_ptr(p.ws);
            norm_phase(wv, (l == 0) ? p.x : (const float*)p.out, p.norm_g + (size_t)(l * 2 + 0) * D, MODL_(wq) + 0 * D, MODL_(wq) + 1 * D, (bf16_t*)(wq + WS_H), l == 0); }
        SEAM(pb + 0);
        if (IN(pb + 1)) { unsigned char* const wq = opaque_ptr(p.ws);
            pg8::SchedProj S; S.o.init(64, 15, G, bid); S.h = (const char*)(wq + WS_H); S.w = (const char*)(WL_(wq) + WO_IN);
            pg8::EpiProj E{(bf16_t*)(wq + WS_P), (bf16_t*)(wq + WS_VT)};
            pg8::gemm_phase(wv, lds, 4096, 4096, D, S, E);
        }
        SEAM(pb + 1);
        if (IN(pb + 2)) prep_phase(wv, p, l, lds);
        SEAM(pb + 2);
        if (IN(pb + 3)) { unsigned char* const wq = opaque_ptr(p.ws);
            volatile LAS int* unext = (volatile LAS int*)(lds + LDS_BYTES - 256 + 64);
            unsigned* ctr = (unsigned*)(wq + WS_BAR) + 3584 + 64 * l;
            for (;;) {
                __syncthreads();
                if (wv == 0 && lane_id_() == 0) *unext = (int)__hip_atomic_fetch_add(ctr, 1u, __ATOMIC_RELAXED, __HIP_MEMORY_SCOPE_AGENT);
                __syncthreads();
                const int u = *unext;
                if (u >= 768) break;
                if (u < 512) { const int g = (u < 256) ? 1 : 0, qt = 63 - ((u & 255) >> 2), b = u & 3;
                    att::unit(wv, p, l, b, g, qt, lds); }
                else {
                    pg8::SchedPoolOne S{(u - 512) >> 2, (u - 512) & 3, (const char*)(wq + WS_POOLED), (const char*)(WL_(wq) + WO_POOL)};
                    pg8::EpiPool E{(bf16_t*)(wq + WS_CONCAT)};
                    pg8::gemm_phase(wv, lds, 2048, 512, 256, S, E); }
            }
            __syncthreads();
        }
        SEAM(pb + 3);
        if (IN(pb + 4)) { unsigned char* const wq = opaque_ptr(p.ws);
            pg8::SchedPlain S; S.o.init(64, 8, G, bid); S.A = (const char*)(wq + WS_CONCAT); S.B = (const char*)(WL_(wq) + WO_OUT); S.tsA = 256 * 4096; S.tsB = 256 * 4096;
            pg8::EpiResid E{(l == 0) ? p.x : (const float*)p.out, p.out, MODL_(wq) + 2 * D};
            pg8::gemm_phase(wv, lds, 4096, 4096, D, S, E);
        }
        SEAM(pb + 4);
        if (IN(pb + 5)) { unsigned char* const wq = opaque_ptr(p.ws);
            norm_phase(wv, p.out, p.norm_g + (size_t)(l * 2 + 1) * D, MODL_(wq) + 3 * D, MODL_(wq) + 4 * D, (bf16_t*)(wq + WS_H), false); }
        SEAM(pb + 5);
        if (IN(pb + 6)) { unsigned char* const wq = opaque_ptr(p.ws);
            pg8::SchedPlain S; S.o.init(64, 44, G, bid); S.A = (const char*)(wq + WS_H); S.B = (const char*)(WL_(wq) + WO_GU); S.tsA = 256 * 4096; S.tsB = 256 * 4096;
            pg8::EpiSwiglu E{(bf16_t*)(wq + WS_ACT)};
            pg8::gemm_phase(wv, lds, 4096, 4096, D, S, E);
        }
        SEAM(pb + 6);
        if (IN(pb + 7)) { unsigned char* const wq = opaque_ptr(p.ws);
            pg8::SchedPlain S; S.o.init(64, 8, G, bid); S.A = (const char*)(wq + WS_ACT); S.B = (const char*)(WL_(wq) + WO_DOWN); S.tsA = (size_t)256 * DFF * 2; S.tsB = (size_t)256 * DFF * 2;
            pg8::EpiResid E{p.out, p.out, MODL_(wq) + 5 * D};
            pg8::gemm_phase(wv, lds, DFF * 2, DFF * 2, DFF, S, E);
        }
        SEAM(pb + 7);
#undef WL_
#undef MODL_
    }
#undef IN
#undef SEAM
}


extern "C" void kernel_launch(void* const* d_in, const int* in_sizes, int n_in, void* d_out, int out_size, void* d_ws, size_t ws_size, hipStream_t stream) {
    static int grid = 0;
    if (grid == 0) {
        if (n_in != 16 || in_sizes[0] != M * D || out_size != M * D || ws_size < WS_END) {
            fprintf(stderr, "kernel_launch: unexpected shapes: n_in %d in0 %d out %d ws %zu (need %zu)\n", n_in, n_in > 0 ? in_sizes[0] : -1, out_size, ws_size, (size_t)WS_END); grid = -1; return; }
        int dev = 0, cus = 0, per_cu = 0;
        (void)hipGetDevice(&dev);
        (void)hipDeviceGetAttribute(&cus, hipDeviceAttributeMultiprocessorCount, dev);
        if (hipFuncSetAttribute((const void*)mega, hipFuncAttributeMaxDynamicSharedMemorySize, LDS_BYTES) != hipSuccess) { fprintf(stderr, "kernel_launch: hipFuncSetAttribute failed\n"); grid = -1; return; }
        if (hipOccupancyMaxActiveBlocksPerMultiprocessor(&per_cu, (const void*)mega, 512, LDS_BYTES) != hipSuccess || per_cu < 1) { fprintf(stderr, "kernel_launch: occupancy query gives %d\n", per_cu); per_cu = 1; }
        (void)hipGetLastError();
        if (cus * per_cu < GRID) fprintf(stderr, "kernel_launch: the device reports room for %d workgroups, the kernel is built for %d\n", cus * per_cu, GRID);
        grid = GRID;
    }
    if (grid < 0) return;
    if (hipMemsetAsync((char*)d_ws + WS_BAR, 0, 16384, stream) != hipSuccess) { fprintf(stderr, "kernel_launch: hipMemsetAsync failed\n"); return; }
    Params p{};
    p.x = (const float*)d_in[0]; p.c = (const float*)d_in[1]; p.w_ada = (const float*)d_in[2]; p.b_ada = (const float*)d_in[3]; p.norm_g = (const float*)d_in[4];
    p.w_in = (const float*)d_in[5]; p.q_gain = (const float*)d_in[6]; p.k_gain = (const float*)d_in[7]; p.pe_cmp = (const float*)d_in[8]; p.w_cmp1 = (const float*)d_in[9];
    p.w_cmp2 = (const float*)d_in[10]; p.w_pool = (const float*)d_in[11]; p.pool_scale = (const float*)d_in[12]; p.w_out = (const float*)d_in[13]; p.w_gate_up = (const float*)d_in[14];
    p.w_down = (const float*)d_in[15]; p.out = (float*)d_out; p.ws = (unsigned char*)d_ws;
#if MK_SINGLE
    p.ph_lo = 0; p.ph_hi = NPH;
    void* args[] = {&p};
    hipError_t e = hipLaunchCooperativeKernel((const void*)mega, dim3(grid), dim3(512), args, LDS_BYTES, stream);
    if (e != hipSuccess) fprintf(stderr, "kernel_launch: cooperative launch failed: %s (grid %d)\n", hipGetErrorString(e), grid);
#else
    for (int ph = 0; ph < NPH; ++ph) {
        p.ph_lo = ph; p.ph_hi = ph + 1;
        hipLaunchKernelGGL(mega, dim3(grid), dim3(512), LDS_BYTES, stream, p);
    }
#endif
}
```

```cpp
#include <hip/hip_runtime.h>
#include <hip/hip_cooperative_groups.h>
#include <cstdio>
#include <cstdint>
namespace cg = cooperative_groups;

#ifndef MK_SINGLE
#define MK_SINGLE 1
#endif

#ifndef PROBE
#define PROBE 0
#endif
#define LAS __attribute__((address_space(3)))
typedef unsigned short bf16_t;
typedef short bf16x8 __attribute__((ext_vector_type(8)));
typedef short s16x4 __attribute__((ext_vector_type(4)));
typedef float f32x4 __attribute__((ext_vector_type(4)));
typedef float f32x2 __attribute__((ext_vector_type(2)));
typedef float f32x16 __attribute__((ext_vector_type(16)));
typedef unsigned u32x4 __attribute__((ext_vector_type(4)));
typedef unsigned u32x2 __attribute__((ext_vector_type(2)));
typedef __bf16 bf16x2n __attribute__((ext_vector_type(2)));
#define DI __device__ __forceinline__

constexpr int D = 2048, NBATCH = 4, T = 4096, M = NBATCH * T, DEPTH = 2;
constexpr int INC = 3608, PWID = 3072, VTR = 768, WINR = 3840, DFF = 5632, NGU = 2 * DFF, MODW = 6 * D;
constexpr int PC_Q = 1024, PC_KC = 2048, PC_VC = 2304, PC_KS = 2560, PC_KW = 2816;
constexpr int VR_VS = 0, VR_VW = 256, VR_GL = 512;
constexpr int NPH = 1 + 8 * DEPTH;
constexpr int GRID = 256;

constexpr size_t MiB = 1u << 20;
constexpr size_t WS_MOD = 0;
constexpr size_t WS_BIAS1 = 512 * 1024;
constexpr size_t WS_BAR = 768 * 1024;
constexpr size_t WS_W = 1 * MiB, WL = 93 * MiB;
constexpr size_t WO_IN = 0, WO_OUT = 15 * MiB, WO_GU = 23 * MiB, WO_DOWN = 67 * MiB, WO_POOL = 89 * MiB, WO_C1 = 90 * MiB, WO_C2 = 92 * MiB;
static_assert(WO_IN + (size_t)WINR * D * 2 <= WO_OUT && WO_OUT + (size_t)D * D * 2 <= WO_GU && WO_GU + (size_t)NGU * D * 2 <= WO_DOWN && WO_DOWN + (size_t)D * DFF * 2 <= WO_POOL &&
              WO_POOL + 4 * 65536 * 2 <= WO_C1 && WO_C1 + (size_t)2 * 128 * 4096 * 2 <= WO_C2 && WO_C2 + 2 * 128 * 128 * 2 <= WL, "weight map");
constexpr size_t WS_H = 187 * MiB;
constexpr size_t WS_P = 251 * MiB;
constexpr size_t WS_VT = 347 * MiB;
constexpr size_t WS_POOLED = 371 * MiB;
constexpr size_t WS_CONCAT = 403 * MiB;
constexpr size_t WS_KCMP = 467 * MiB;
constexpr size_t WS_VCMP = 467 * MiB + 512 * 1024;
constexpr size_t WS_ACT = WS_P;
constexpr size_t WS_END = 468 * MiB;
static_assert(WS_W + 2 * WL <= WS_H && WS_H + (size_t)M * D * 2 <= WS_P && WS_P + (size_t)M * PWID * 2 <= WS_VT && WS_VT + (size_t)VTR * M * 2 <= WS_POOLED &&
              WS_POOLED + (size_t)M * 1024 * 2 <= WS_CONCAT && WS_CONCAT + (size_t)M * D * 2 <= WS_KCMP, "ws map");
static_assert(WS_ACT + (size_t)M * DFF * 2 <= WS_KCMP, "act overlay");

constexpr int LDS_BYTES = 155648;

struct Params {
    const float *x, *c, *w_ada, *b_ada, *norm_g, *w_in, *q_gain, *k_gain, *pe_cmp, *w_cmp1, *w_cmp2, *w_pool, *pool_scale, *w_out, *w_gate_up, *w_down;
    float* out; unsigned char* ws; int ph_lo, ph_hi;
};

DI int lane_id_() { unsigned m = ~0u; asm volatile("" : "+s"(m)); return (int)__builtin_amdgcn_mbcnt_hi(m, __builtin_amdgcn_mbcnt_lo(m, 0u)); }
#define TID_FROM_WV(wv) int tid = (wv) * 64 + lane_id_(); asm volatile("" : "+v"(tid));
DI unsigned pk2(float lo, float hi) { f32x2 v = {lo, hi}; bf16x2n b = __builtin_convertvector(v, bf16x2n); return __builtin_bit_cast(unsigned, b); }
DI float bf2f(unsigned short u) { return __builtin_bit_cast(float, (unsigned)u << 16); }
DI float bflo(unsigned u) { return __builtin_bit_cast(float, u << 16); }
DI float bfhi(unsigned u) { return __builtin_bit_cast(float, u & 0xffff0000u); }
DI float fast_exp2(float x) { return __builtin_amdgcn_exp2f(x); }
DI float fast_rcp(float x) { return __builtin_amdgcn_rcpf(x); }
DI float silu_f(float x) { return x * fast_rcp(1.f + fast_exp2(-1.44269504f * x)); }
DI float sigmoid_f(float x) { return fast_rcp(1.f + fast_exp2(-1.44269504f * x)); }

namespace pg8 {
constexpr int BM = 256, BK = 64, HALF = 128, HTB = HALF * BK * 2, NXCD = 8, WGM = 8;
DI int lds_byte(int r, int c) { const int st = (r >> 4) * 2 + (c >> 5), rr = r & 15, cc = c & 31, ob = rr * 64 + cc * 2; return st * 1024 + (ob ^ (((ob >> 9) & 1) << 5)); }
DI void stage_rc(int b, int& R, int& C) { const int st = b / 1024, sb = b % 1024, swz = sb ^ (((sb >> 9) & 1) << 5); R = (st >> 1) * 16 + swz / 64; C = (st & 1) * 32 + (swz % 64) / 2; }
DI int perm32(int rho) { const int n = rho >> 4, i = rho & 15; return 8 * (i >> 2) + 4 * n + (i & 3); }

struct Unit { const char* a; const char* b; int pm, pn; };

struct TileOrder {
    int nM, nN, nwg, G, c;
    DI void init(int nM_, int nN_, int G_, int c_) { nM = nM_; nN = nN_; nwg = nM * nN; G = G_; c = c_; }
    DI bool tile(int i, int& pm, int& pn) const {
        const long L = (long)i * G + c; if (L >= nwg) return false;
        int wgid = (int)L; { const int q = nwg / NXCD, r = nwg % NXCD, xcd = wgid % NXCD, off = wgid / NXCD; wgid = (xcd < r ? xcd * (q + 1) : r * (q + 1) + (xcd - r) * q) + off; }
        const int nig = WGM * nN, gid = wgid / nig, fm = gid * WGM, gsz = (nM - fm) < WGM ? (nM - fm) : WGM;
        pm = fm + ((wgid % nig) % gsz); pn = (wgid % nig) / gsz; return true;
    }
};

template <class Epi, class Sched>
DI void gemm_phase(const int wv, LAS unsigned char* lds, const int lda, const int ldb, const int K, const Sched& S, const Epi& E) {
    TID_FROM_WV(wv)
    const int wid = __builtin_amdgcn_readfirstlane(tid >> 6), lane = tid & 63, wr = wid >> 2, wc = wid & 3, fr = lane & 15, fq = lane >> 4;
    const int nt = K / BK;
    unsigned voffA[2], voffB[2];
#pragma unroll
    for (int i = 0; i < 2; ++i) { int R, C; stage_rc(tid * 16 + i * 8192, R, C); const int Rb = (R & ~31) + perm32(R & 31);
        voffA[i] = (unsigned)(R * lda + C * 2); voffB[i] = (unsigned)(Rb * ldb + C * 2); }
    const size_t kstep = (size_t)(BK * 2);
    const size_t hstepA = (size_t)HALF * lda, hstepB = (size_t)HALF * ldb;
    const unsigned ldsw = (unsigned)wid * 1024u;
    const int aoff = lds_byte(wr * 64 + fr, fq * 8), boff = lds_byte(wc * 32 + fr, fq * 8);
#define PG8_SA(b, h) (((b) * 2 + (h)) * HTB)
#define PG8_SB(b, h) ((4 + (b) * 2 + (h)) * HTB)
#define PG8_STAGE(bufoff, gbase, voff) do { _Pragma("unroll") for (int _i = 0; _i < 2; ++_i) \
        __builtin_amdgcn_global_load_lds((const unsigned*)((const char*)(gbase) + (voff)[_i]), (LAS unsigned*)(lds + (bufoff) + ldsw + _i * 8192), 16, 0, 0); } while (0)
#define PG8_LDA(dst, b, h) do { _Pragma("unroll") for (int m = 0; m < 4; ++m) _Pragma("unroll") for (int k = 0; k < 2; ++k) dst[m][k] = *(const LAS bf16x8*)(lds + PG8_SA(b, h) + aoff + m * 2048 + k * 1024); } while (0)
#define PG8_LDB(dst, b, h) do { _Pragma("unroll") for (int n = 0; n < 2; ++n) _Pragma("unroll") for (int k = 0; k < 2; ++k) dst[n][k] = *(const LAS bf16x8*)(lds + PG8_SB(b, h) + boff + n * 2048 + k * 1024); } while (0)
#define PG8_MMA(ai, bj, At, Bt) do { __builtin_amdgcn_s_setprio(1); _Pragma("unroll") for (int m = 0; m < 4; ++m) _Pragma("unroll") for (int n = 0; n < 2; ++n) _Pragma("unroll") for (int k = 0; k < 2; ++k) \
        acc[ai][bj][m][n] = __builtin_amdgcn_mfma_f32_16x16x32_bf16(Bt[n][k], At[m][k], acc[ai][bj][m][n], 0, 0, 0); __builtin_amdgcn_s_setprio(0); } while (0)
#define PG8_WAIT_V(n) asm volatile("s_waitcnt vmcnt(" #n ")" ::: "memory")
#define PG8_WAIT_L(n) asm volatile("s_waitcnt lgkmcnt(" #n ")" ::: "memory")
#define PG8_BAR __builtin_amdgcn_s_barrier()
#define PG8_SCHED __builtin_amdgcn_sched_barrier(0)
    Unit cur, nxt; int ui = 0;
    if (!S.next(0, cur)) return;
    f32x4 acc[2][2][4][2];
#pragma unroll
    for (int a = 0; a < 2; ++a)
#pragma unroll
        for (int b = 0; b < 2; ++b)
#pragma unroll
            for (int m = 0; m < 4; ++m)
#pragma unroll
                for (int n = 0; n < 2; ++n) acc[a][b][m][n] = (f32x4){0.f, 0.f, 0.f, 0.f};
    bf16x8 At[4][2], B0[2][2], B1[2][2];
    const char* cA = cur.a; const char* cB = cur.b;
    PG8_STAGE(PG8_SB(0, 0), cB, voffB); PG8_STAGE(PG8_SB(0, 1), cB + hstepB, voffB); PG8_STAGE(PG8_SA(0, 0), cA, voffA); PG8_STAGE(PG8_SA(0, 1), cA + hstepA, voffA);
    if (wr == 1) PG8_BAR;
    PG8_WAIT_V(2); PG8_BAR;
    PG8_STAGE(PG8_SB(1, 0), cB + kstep, voffB); PG8_STAGE(PG8_SA(1, 0), cA + kstep, voffA); PG8_STAGE(PG8_SB(1, 1), cB + hstepB + kstep, voffB);
    PG8_WAIT_V(6); PG8_BAR;
    for (;;) {
        const bool has_next = S.next(ui + 1, nxt);
        const char* nA = has_next ? nxt.a : cA; const char* nB = has_next ? nxt.b : cB;
#pragma unroll 1
        for (int t = 0; t < nt; t += 2) {
            const bool last = (t == nt - 2);
            const char* a1 = cA + (size_t)(t + 1) * kstep;
            const char* a2 = last ? nA : cA + (size_t)(t + 2) * kstep; const char* b2 = last ? nB : cB + (size_t)(t + 2) * kstep;
            const char* a3 = a2 + kstep; const char* b3 = b2 + kstep;
            PG8_LDB(B0, 0, 0); PG8_LDB(B1, 0, 1); PG8_SCHED; PG8_LDA(At, 0, 0); PG8_STAGE(PG8_SA(1, 1), a1 + hstepA, voffA);
            PG8_WAIT_V(8); PG8_WAIT_L(0); PG8_BAR; PG8_MMA(0, 0, At, B0); PG8_MMA(0, 1, At, B1); PG8_BAR; PG8_SCHED;
            PG8_LDA(At, 0, 1); PG8_STAGE(PG8_SB(0, 0), b2, voffB); PG8_STAGE(PG8_SB(0, 1), b2 + hstepB, voffB); PG8_STAGE(PG8_SA(0, 0), a2, voffA);
            PG8_WAIT_V(8); PG8_WAIT_L(0); PG8_BAR; PG8_MMA(1, 0, At, B0); PG8_MMA(1, 1, At, B1); PG8_BAR; PG8_SCHED;
            PG8_LDB(B0, 1, 0); PG8_LDB(B1, 1, 1); PG8_SCHED; PG8_LDA(At, 1, 0); PG8_STAGE(PG8_SA(0, 1), a2 + hstepA, voffA);
            PG8_WAIT_V(8); PG8_WAIT_L(0); PG8_BAR; PG8_MMA(0, 0, At, B0); PG8_MMA(0, 1, At, B1); PG8_BAR; PG8_SCHED;
            PG8_LDA(At, 1, 1); PG8_STAGE(PG8_SB(1, 0), b3, voffB); PG8_STAGE(PG8_SB(1, 1), b3 + hstepB, voffB); PG8_STAGE(PG8_SA(1, 0), a3, voffA);
            PG8_WAIT_V(8); PG8_WAIT_L(0); PG8_BAR; PG8_MMA(1, 0, At, B0); PG8_MMA(1, 1, At, B1); PG8_BAR; PG8_SCHED;
        }
        if (wr == 0) PG8_BAR;
        E(acc, cur, wr, wc, fr, fq);
        if (!has_next) break;
#pragma unroll
        for (int a = 0; a < 2; ++a)
#pragma unroll
            for (int b = 0; b < 2; ++b)
#pragma unroll
                for (int m = 0; m < 4; ++m)
#pragma unroll
                    for (int n = 0; n < 2; ++n) acc[a][b][m][n] = (f32x4){0.f, 0.f, 0.f, 0.f};
        cur = nxt; cA = nA; cB = nB; ++ui;
        if (wr == 1) PG8_BAR;
    }
    PG8_WAIT_V(0);
    PG8_BAR;
#undef PG8_SA
#undef PG8_SB
#undef PG8_STAGE
#undef PG8_LDA
#undef PG8_LDB
#undef PG8_MMA
#undef PG8_WAIT_V
#undef PG8_WAIT_L
#undef PG8_BAR
#undef PG8_SCHED
}

struct SchedProj { TileOrder o; const char* h; const char* w;
    DI bool next(int i, Unit& u) const { int pm, pn; if (!o.tile(i, pm, pn)) return false; u.pm = pm; u.pn = pn;
        const char* hp = h + (size_t)pm * (256 * 4096); const char* wp = w + (size_t)pn * (256 * 4096);
        if (pn < 12) { u.a = hp; u.b = wp; } else { u.a = wp; u.b = hp; } return true; } };
struct SchedPlain { TileOrder o; const char* A; const char* B; size_t tsA, tsB;
    DI bool next(int i, Unit& u) const { int pm, pn; if (!o.tile(i, pm, pn)) return false; u.pm = pm; u.pn = pn; u.a = A + (size_t)pm * tsA; u.b = B + (size_t)pn * tsB; return true; } };
struct SchedWeff { int G, c; const char* wbase;
    DI bool next(int i, Unit& u) const { const int L = i * G + c; if (L >= 64) return false; const int l = L >> 5, pmw = (L >> 2) & 7, g = L & 3; u.pm = l * 8 + pmw; u.pn = g;
        const char* wl_ = wbase + (size_t)l * WL; u.a = wl_ + WO_OUT + (size_t)pmw * (256 * 4096) + g * 512; u.b = wl_ + WO_POOL + (size_t)g * (65536 * 2); return true; } };
struct SchedPoolOne { int pm, pn; const char* A; const char* B;
    DI bool next(int i, Unit& u) const { if (i != 0) return false; u.pm = pm; u.pn = pn; u.a = A + (size_t)pm * (256 * 2048) + pn * 512; u.b = B + (size_t)pn * (256 * 512); return true; } };
struct SchedPool { TileOrder o; const char* A; const char* B;
    DI bool next(int i, Unit& u) const { int pm, pn; if (!o.tile(i, pm, pn)) return false; u.pm = pm; u.pn = pn; u.a = A + (size_t)pm * (256 * 2048) + pn * 512; u.b = B + (size_t)pn * (256 * 512); return true; } };

DI void store_bf16_tile(const f32x4 (&acc)[2][2][4][2], bf16_t* O, long ldc, int rb, int cb, int wr, int wc, int fr, int fq) {
    const int row0 = rb + wr * 64 + fr, col0 = cb + wc * 32 + 8 * fq;
#pragma unroll
    for (int ai = 0; ai < 2; ++ai)
#pragma unroll
        for (int m = 0; m < 4; ++m) { bf16_t* rowp = O + (size_t)(row0 + ai * HALF + m * 16) * ldc + col0;
#pragma unroll
            for (int bj = 0; bj < 2; ++bj) { const f32x4 v0 = acc[ai][bj][m][0], v1 = acc[ai][bj][m][1];
                u32x4 w; w.x = pk2(v0[0], v0[1]); w.y = pk2(v0[2], v0[3]); w.z = pk2(v1[0], v1[1]); w.w = pk2(v1[2], v1[3]);
                *(u32x4*)(rowp + bj * HALF) = w; } }
}
struct EpiWeff { unsigned char* wbase;
    DI void operator()(const f32x4 (&acc)[2][2][4][2], const Unit& u, int wr, int wc, int fr, int fq) const {
        store_bf16_tile(acc, (bf16_t*)(wbase + (size_t)(u.pm >> 3) * WL + WO_OUT), D, (u.pm & 7) * 256, u.pn * 256, wr, wc, fr, fq); } };
struct EpiProj { bf16_t* P; bf16_t* Vt;
    DI void operator()(const f32x4 (&acc)[2][2][4][2], const Unit& u, int wr, int wc, int fr, int fq) const {
        if (u.pn < 12) store_bf16_tile(acc, P, PWID, u.pm * 256, u.pn * 256, wr, wc, fr, fq);
        else store_bf16_tile(acc, Vt, M, (u.pn - 12) * 256, u.pm * 256, wr, wc, fr, fq);
    } };
struct EpiPool { bf16_t* O;
    DI void operator()(const f32x4 (&acc)[2][2][4][2], const Unit& u, int wr, int wc, int fr, int fq) const { store_bf16_tile(acc, O, D, u.pm * 256, u.pn * 256, wr, wc, fr, fq); } };
struct EpiResid { const float* xin; float* xout; const float* gate;
    DI void operator()(const f32x4 (&acc)[2][2][4][2], const Unit& u, int wr, int wc, int fr, int fq) const {
        const int row0 = u.pm * 256 + wr * 64 + fr, col0 = u.pn * 256 + wc * 32 + 8 * fq; const float* gp = gate + (size_t)(u.pm >> 4) * MODW + col0;
        f32x4 gv[2][2];
#pragma unroll
        for (int bj = 0; bj < 2; ++bj) { gv[bj][0] = *(const f32x4*)(gp + bj * HALF); gv[bj][1] = *(const f32x4*)(gp + bj * HALF + 4); }
#pragma unroll
        for (int ai = 0; ai < 2; ++ai)
#pragma unroll
            for (int m = 0; m < 4; ++m) { const size_t ro = (size_t)(row0 + ai * HALF + m * 16) * D + col0;
#pragma unroll
                for (int bj = 0; bj < 2; ++bj) { const float* xi = xin + ro + bj * HALF; float* xo = xout + ro + bj * HALF;
                    const f32x4 a0 = *(const f32x4*)xi, a1 = *(const f32x4*)(xi + 4);
                    *(f32x4*)xo = a0 + gv[bj][0] * acc[ai][bj][m][0]; *(f32x4*)(xo + 4) = a1 + gv[bj][1] * acc[ai][bj][m][1]; } }
    } };
struct EpiSwiglu { bf16_t* act;
    DI void operator()(const f32x4 (&acc)[2][2][4][2], const Unit& u, int wr, int wc, int fr, int fq) const {
        const int row0 = u.pm * 256 + wr * 64 + fr, col0 = u.pn * 128 + wc * 32 + 8 * fq;
#pragma unroll
        for (int ai = 0; ai < 2; ++ai)
#pragma unroll
            for (int m = 0; m < 4; ++m) { float v[8];
#pragma unroll
                for (int n = 0; n < 2; ++n)
#pragma unroll
                    for (int e = 0; e < 4; ++e) v[4 * n + e] = silu_f(acc[ai][0][m][n][e]) * acc[ai][1][m][n][e];
                u32x4 w; w.x = pk2(v[0], v[1]); w.y = pk2(v[2], v[3]); w.z = pk2(v[4], v[5]); w.w = pk2(v[6], v[7]);
                *(u32x4*)(act + (size_t)(row0 + ai * HALF + m * 16) * DFF + col0) = w; }
    } };
}

DI void tr_item(const float* src, int src_ld, int col0, int lim, int k0, bf16_t* dst, int K, int n0, const float* scale, LAS float* scr, int lane) {
    float v[32];
#pragma unroll
    for (int i = 0; i < 32; ++i) { const int kk = 2 * i + (lane >> 5), cc = col0 + (lane & 31);
        v[i] = (cc < lim) ? __builtin_nontemporal_load(src + (size_t)(k0 + kk) * src_ld + cc) : 0.f; }
#pragma unroll
    for (int i = 0; i < 32; ++i) { const int kk = 2 * i + (lane >> 5); scr[kk * 33 + (lane & 31)] = v[i]; }
    asm volatile("s_waitcnt lgkmcnt(0)" ::: "memory");
    const int c = lane & 7;
#pragma unroll
    for (int j = 0; j < 4; ++j) { const int n = (lane >> 3) + 8 * j; const LAS float* s = scr + (8 * c) * 33 + n; const float sc = scale ? scale[n0 + n] : 1.f;
        u32x4 o; o.x = pk2(s[0 * 33] * sc, s[1 * 33] * sc); o.y = pk2(s[2 * 33] * sc, s[3 * 33] * sc); o.z = pk2(s[4 * 33] * sc, s[5 * 33] * sc); o.w = pk2(s[6 * 33] * sc, s[7 * 33] * sc);
        *(u32x4*)(dst + (size_t)(n0 + n) * K + k0 + 8 * c) = o; }
    asm volatile("s_waitcnt lgkmcnt(0)" ::: "memory");
}

DI void phase0(const int wv, const Params& p, LAS unsigned char* lds) {
    TID_FROM_WV(wv)
    const int lane = tid & 63, wave = tid >> 6, G = GRID, bid = blockIdx.x;
    float* mod = (float*)(p.ws + WS_MOD); float* bias1 = (float*)(p.ws + WS_BIAS1);
    for (int it = bid; it < 196; it += G) {
        __syncthreads();
        if (it < 192) {
            const int l = it / 96, j0 = (it % 96) * 128;
            LAS float* cond = (LAS float*)lds;
            LAS float* red = (LAS float*)(lds + 32768);
            for (int i = tid; i < 4 * D; i += 512) cond[i] = silu_f(p.c[i]);
            __syncthreads();
            float acc[4][2] = {};
            const float* wp = p.w_ada + ((size_t)l * D + wave * 256) * MODW + j0 + 2 * lane;
            for (int k0 = 0; k0 < 256; k0 += 16) { f32x2 wv[16];
#pragma unroll
                for (int u = 0; u < 16; ++u) wv[u] = __builtin_nontemporal_load((const f32x2*)(wp + (size_t)(k0 + u) * MODW));
#pragma unroll
                for (int u = 0; u < 16; ++u)
#pragma unroll
                    for (int b = 0; b < 4; ++b) { const float cb = cond[b * D + wave * 256 + k0 + u]; acc[b][0] += cb * wv[u].x; acc[b][1] += cb * wv[u].y; } }
#pragma unroll
            for (int b = 0; b < 4; ++b) { red[(wave * 4 + b) * 128 + 2 * lane] = acc[b][0]; red[(wave * 4 + b) * 128 + 2 * lane + 1] = acc[b][1]; }
            __syncthreads();
            { const int b = tid >> 7, col = tid & 127; float s = p.b_ada[(size_t)l * MODW + j0 + col];
#pragma unroll
              for (int w = 0; w < 8; ++w) s += red[(w * 4 + b) * 128 + col];
              mod[((size_t)l * 4 + b) * MODW + j0 + col] = s; }
        } else {
            const int l = (it - 192) >> 1, kv = (it - 192) & 1;
            LAS float* red = (LAS float*)lds;
            const int n = tid & 127, kc = tid >> 7;
            const float* pe = p.pe_cmp + ((size_t)(l * 2 + kv)) * 4096 + kc * 1024;
            const float* w1 = p.w_cmp1 + ((size_t)(l * 2 + kv) * 4096 + kc * 1024) * 128 + n;
            float s = 0.f;
#pragma unroll 8
            for (int k = 0; k < 1024; ++k) s += pe[k] * w1[(size_t)k * 128];
            red[kc * 128 + n] = s;
            __syncthreads();
            if (tid < 128) bias1[(l * 2 + kv) * 128 + tid] = red[tid] + red[128 + tid] + red[256 + tid] + red[384 + tid];
        }
    }
    __syncthreads();
    LAS float* scr = (LAS float*)(lds + wave * 8704);
    unsigned* tctr = (unsigned*)(p.ws + WS_BAR) + 3712;
    constexpr int I_IN = (WINR / 32) * (D / 64), I_OUT = (D / 32) * (D / 64), I_GU = (NGU / 32) * (D / 64), I_DN = (D / 32) * (DFF / 64), I_PL = 4 * 8 * 4, I_C1 = 2 * 4 * 64, I_C2 = 2 * 4 * 2;
    constexpr int I_LAYER = I_IN + I_OUT + I_GU + I_DN + I_PL + I_C1 + I_C2;
    volatile LAS int* cslot = (volatile LAS int*)(lds + LDS_BYTES - 256 + 128);
    for (;;) {
    __syncthreads();
    if (tid == 0) *cslot = (int)__hip_atomic_fetch_add(tctr, 64u, __ATOMIC_RELAXED, __HIP_MEMORY_SCOPE_AGENT);
    __syncthreads();
    const int cbase = *cslot;
    if (cbase >= DEPTH * I_LAYER) break;
    for (int it = cbase + wave; it < cbase + 64 && it < DEPTH * I_LAYER; it += 8) {
        const int itr = DEPTH * I_LAYER - 1 - it;
        const int l = itr / I_LAYER; int r = itr % I_LAYER;
        unsigned char* wl = p.ws + WS_W + (size_t)l * WL;
        if (r < I_IN) { const int kb = r / (WINR / 32), nb = r % (WINR / 32); const int n0 = nb * 32;
            int col0 = n0; if (n0 >= 2816 && n0 < 3072) col0 = n0 + 256; else if (n0 >= 3072 && n0 < 3328) col0 = n0 - 256;
            const int lim = (n0 >= 3616) ? 0 : INC;
            tr_item(p.w_in + (size_t)l * D * INC, INC, col0, lim, kb * 64, (bf16_t*)(wl + WO_IN), D, n0, nullptr, scr, lane); continue; } r -= I_IN;
        if (r < I_OUT) { const int kb = r / (D / 32), nb = r % (D / 32);
            tr_item(p.w_out + (size_t)l * D * D, D, nb * 32, D, kb * 64, (bf16_t*)(wl + WO_OUT), D, nb * 32, nullptr, scr, lane); continue; } r -= I_OUT;
        if (r < I_GU) { const int kb = r / (NGU / 32), nb = r % (NGU / 32); const int n0 = nb * 32; const int pn = n0 >> 8, bj = (n0 >> 7) & 1, i0 = n0 & 127;
            tr_item(p.w_gate_up + (size_t)l * D * NGU, NGU, bj * DFF + pn * 128 + i0, NGU, kb * 64, (bf16_t*)(wl + WO_GU), D, n0, nullptr, scr, lane); continue; } r -= I_GU;
        if (r < I_DN) { const int kb = r / (D / 32), nb = r % (D / 32);
            tr_item(p.w_down + (size_t)l * DFF * D, D, nb * 32, D, kb * 64, (bf16_t*)(wl + WO_DOWN), DFF, nb * 32, nullptr, scr, lane); continue; } r -= I_DN;
        if (r < I_PL) { const int g = r >> 5, nb = (r >> 2) & 7, kb = r & 3;
            tr_item(p.w_pool + ((size_t)l * 4 + g) * 65536, 256, nb * 32, 256, kb * 64, (bf16_t*)(wl + WO_POOL) + (size_t)g * 65536, 256, nb * 32, p.pool_scale + (size_t)l * 1024 + g * 256, scr, lane); continue; } r -= I_PL;
        if (r < I_C1) { const int kv = r >> 8, nb = (r >> 6) & 3, kb = r & 63;
            tr_item(p.w_cmp1 + ((size_t)l * 2 + kv) * 4096 * 128, 128, nb * 32, 128, kb * 64, (bf16_t*)(wl + WO_C1) + (size_t)kv * 128 * 4096, 4096, nb * 32, nullptr, scr, lane); continue; } r -= I_C1;
        { const int kv = r >> 3, nb = (r >> 1) & 3, kb = r & 1;
            tr_item(p.w_cmp2 + ((size_t)l * 2 + kv) * 128 * 128, 128, nb * 32, 128, kb * 64, (bf16_t*)(wl + WO_C2) + (size_t)kv * 128 * 128, 128, nb * 32, nullptr, scr, lane); }
    }
    }
}

DI void norm_phase(const int wv, const float* xin, const float* gvec, const float* sh, const float* sc, bf16_t* hout) {
    TID_FROM_WV(wv)
    const int lane = tid & 63, wave = tid >> 6, gw = blockIdx.x * 8 + wave;
    static_assert(GRID * 8 * 8 == M, "each wave owns 8 consecutive rows of one batch");
    const int b = gw >> 9, r0 = gw * 8;
    f32x4 gp[8], hh[8];
#pragma unroll
    for (int j = 0; j < 8; ++j) { const int col = 4 * lane + 256 * j;
        gp[j] = *(const f32x4*)(gvec + col) * (*(const f32x4*)(sc + (size_t)b * MODW + col) + 1.f); hh[j] = *(const f32x4*)(sh + (size_t)b * MODW + col); }
    f32x4 v[8], vn[8];
    { const f32x4* xr = (const f32x4*)(xin + (size_t)r0 * D) + lane;
#pragma unroll
      for (int j = 0; j < 8; ++j) v[j] = xr[64 * j]; }
#pragma unroll
    for (int k = 0; k < 8; ++k) {
        const int m = r0 + k;
        if (k < 7) { const f32x4* xr = (const f32x4*)(xin + (size_t)(m + 1) * D) + lane;
#pragma unroll
            for (int j = 0; j < 8; ++j) vn[j] = xr[64 * j]; }
        float s = 0.f;
#pragma unroll
        for (int j = 0; j < 8; ++j) s += (v[j].x * v[j].x + v[j].y * v[j].y) + (v[j].z * v[j].z + v[j].w * v[j].w);
#pragma unroll
        for (int o = 1; o < 64; o <<= 1) s += __shfl_xor(s, o);
        const float rstd = rsqrtf(s * (1.f / D) + 1e-6f);
        u32x2* o8 = (u32x2*)(hout + (size_t)m * D) + lane;
#pragma unroll
        for (int j = 0; j < 8; ++j) { const f32x4 y = v[j] * rstd * gp[j] + hh[j];
            u32x2 w; w.x = pk2(y.x, y.y); w.y = pk2(y.z, y.w); o8[64 * j] = w; }
#pragma unroll
        for (int j = 0; j < 8; ++j) v[j] = vn[j];
    }
}

template <int W>
DI void pool_item(const bf16_t* P, bf16_t* pooled, const size_t m0, const int c8) {
    const int t0 = (int)(m0 & (size_t)(T - 1));
    u32x4 raw[W + 3];
#pragma unroll
    for (int k = 0; k < W + 3; ++k) { const int dt = k - (W - 1);
        raw[k] = (t0 + dt >= 0) ? *(const u32x4*)(P + (size_t)((long)m0 + dt) * PWID + c8) : (u32x4){0u, 0u, 0u, 0u}; }
    float s[8] = {0.f, 0.f, 0.f, 0.f, 0.f, 0.f, 0.f, 0.f};
#pragma unroll
    for (int k = 0; k < W; ++k) { s[0] += bflo(raw[k].x); s[1] += bfhi(raw[k].x); s[2] += bflo(raw[k].y); s[3] += bfhi(raw[k].y); s[4] += bflo(raw[k].z); s[5] += bfhi(raw[k].z); s[6] += bflo(raw[k].w); s[7] += bfhi(raw[k].w); }
#pragma unroll
    for (int j = 0; j < 4; ++j) {
        const int cnt = (t0 + j + 1 < W) ? t0 + j + 1 : W; const float inv = 1.f / (float)cnt;
        const u32x4 c = raw[j + W - 1];
        u32x4 o; o.x = pk2(s[0] * inv - bflo(c.x), s[1] * inv - bfhi(c.x)); o.y = pk2(s[2] * inv - bflo(c.y), s[3] * inv - bfhi(c.y));
        o.z = pk2(s[4] * inv - bflo(c.z), s[5] * inv - bfhi(c.z)); o.w = pk2(s[6] * inv - bflo(c.w), s[7] * inv - bfhi(c.w));
        *(u32x4*)(pooled + (m0 + j) * 1024 + c8) = o;
        if (j < 3) { const u32x4 a = raw[j + W], d = raw[j];
            s[0] += bflo(a.x) - bflo(d.x); s[1] += bfhi(a.x) - bfhi(d.x); s[2] += bflo(a.y) - bflo(d.y); s[3] += bfhi(a.y) - bfhi(d.y);
            s[4] += bflo(a.z) - bflo(d.z); s[5] += bfhi(a.z) - bfhi(d.z); s[6] += bflo(a.w) - bflo(d.w); s[7] += bfhi(a.w) - bfhi(d.w); }
    }
}

DI void prep_phase(const int wv, const Params& p, int l, LAS unsigned char* lds) {
    TID_FROM_WV(wv)
    const int lane = tid & 63, wave = tid >> 6, G = GRID, bid = blockIdx.x;
    bf16_t* P = (bf16_t*)(p.ws + WS_P);
    {
        const unsigned char* wl = p.ws + WS_W + (size_t)l * WL;
        const float* bias1 = (const float*)(p.ws + WS_BIAS1) + l * 256;
        bf16_t* kcmp = (bf16_t*)(p.ws + WS_KCMP); bf16_t* vcmp = (bf16_t*)(p.ws + WS_VCMP);
        LAS bf16_t* Hs = (LAS bf16_t*)lds;
        LAS float* red = (LAS float*)(lds + 8192);
        LAS float* part = (LAS float*)(lds + 16384);
        const int r16 = lane & 15, kq = lane >> 4;
        for (int u = bid; u < 256; u += G) {
            const int ch = u & 15, g = (u >> 4) & 1, b = (u >> 5) & 3, kv = u >> 7, c0 = ch * 16;
            const bf16_t* W1t = (const bf16_t*)(wl + WO_C1) + (size_t)kv * 128 * 4096;
            const bf16_t* W2t = (const bf16_t*)(wl + WO_C2) + (size_t)kv * 128 * 128;
            const bf16_t* Arow = P + ((size_t)b * T + 16 * (c0 + r16)) * PWID + (kv ? PC_VC : PC_KC) + g * 128 + 8 * kq;
            const bf16_t* Brow = W1t + (size_t)r16 * 4096 + 8 * kq;
            f32x4 acc[8];
#pragma unroll
            for (int nt = 0; nt < 8; ++nt) acc[nt] = (f32x4){0.f, 0.f, 0.f, 0.f};
#pragma unroll 2
            for (int kk = 0; kk < 16; ++kk) { const int ks = 16 * wave + kk;
                const bf16x8 a = *(const bf16x8*)(Arow + (size_t)(ks >> 2) * PWID + (ks & 3) * 32);
#pragma unroll
                for (int nt = 0; nt < 8; ++nt) { const bf16x8 bb = *(const bf16x8*)(Brow + (size_t)nt * 16 * 4096 + ks * 32);
                    acc[nt] = __builtin_amdgcn_mfma_f32_16x16x32_bf16(a, bb, acc[nt], 0, 0, 0); }
            }
            __syncthreads();
#pragma unroll
            for (int nt = 0; nt < 8; ++nt)
#pragma unroll
                for (int i = 0; i < 4; ++i) part[(wave * 16 + 4 * kq + i) * 128 + 16 * nt + r16] = acc[nt][i];
            __syncthreads();
            { const int row = tid >> 5, n4 = (tid & 31) * 4; f32x4 s = *(const f32x4*)(bias1 + kv * 128 + n4);
#pragma unroll
              for (int w = 0; w < 8; ++w) s += *(const LAS f32x4*)(part + (w * 16 + row) * 128 + n4);
              u32x2 hv; hv.x = pk2(silu_f(s.x), silu_f(s.y)); hv.y = pk2(silu_f(s.z), silu_f(s.w));
              *(LAS u32x2*)(Hs + row * 136 + n4) = hv; }
            __syncthreads();
            f32x4 acc2 = {0.f, 0.f, 0.f, 0.f};
#pragma unroll
            for (int ks = 0; ks < 4; ++ks) {
                const bf16x8 a = *(const LAS bf16x8*)(Hs + r16 * 136 + ks * 32 + 8 * kq);
                const bf16x8 bb = *(const bf16x8*)(W2t + (size_t)(16 * wave + r16) * 128 + ks * 32 + 8 * kq);
                acc2 = __builtin_amdgcn_mfma_f32_16x16x32_bf16(a, bb, acc2, 0, 0, 0);
            }
            const int n = 16 * wave + r16;
            if (kv == 0) {
                float ss[4];
#pragma unroll
                for (int i = 0; i < 4; ++i) { float s = acc2[i] * acc2[i]; s += __shfl_xor(s, 1); s += __shfl_xor(s, 2); s += __shfl_xor(s, 4); s += __shfl_xor(s, 8); ss[i] = s; }
                if (r16 == 0) {
#pragma unroll
                    for (int i = 0; i < 4; ++i) red[wave * 16 + 4 * kq + i] = ss[i]; }
                __syncthreads();
                const float gn = p.k_gain[(l * 3 + 0) * 128 + n];
#pragma unroll
                for (int i = 0; i < 4; ++i) { const int row = 4 * kq + i; float s = 0.f;
#pragma unroll
                    for (int w = 0; w < 8; ++w) s += red[w * 16 + row];
                    const float rstd = rsqrtf(s * (1.f / 128.f) + 1e-6f); const int c = c0 + row;
                    const float v = (c < 255) ? acc2[i] * rstd * gn : 0.f;
                    kcmp[(((size_t)b * 2 + g) * 256 + c) * 128 + n] = (bf16_t)(pk2(v, 0.f) & 0xffffu); }
            } else {
                float v[4];
#pragma unroll
                for (int i = 0; i < 4; ++i) v[i] = (c0 + 4 * kq + i < 255) ? acc2[i] : 0.f;
                u32x2 w; w.x = pk2(v[0], v[1]); w.y = pk2(v[2], v[3]);
                *(u32x2*)(vcmp + (((size_t)b * 2 + g) * 128 + n) * 256 + c0 + 4 * kq) = w;
            }
        }
    }
    {
        static_assert(GRID * 8 * 8 == M, "each wave owns 8 consecutive tokens");
        const int sub = lane & 15, g4 = lane >> 4, gw = bid * 8 + wave;
        float gq[8], gk[8];
        { const float* gqp = p.q_gain + l * 128 + 8 * sub; const float* gkp = p.k_gain + (l * 3 + ((g4 < 2) ? 1 : 2)) * 128 + 8 * sub;
          const f32x4 a0 = *(const f32x4*)gqp, a1 = *(const f32x4*)(gqp + 4), b0 = *(const f32x4*)gkp, b1 = *(const f32x4*)(gkp + 4);
          const float qs = 0.08838834764831845f * 1.44269504f;
          gq[0] = a0.x * qs; gq[1] = a0.y * qs; gq[2] = a0.z * qs; gq[3] = a0.w * qs; gq[4] = a1.x * qs; gq[5] = a1.y * qs; gq[6] = a1.z * qs; gq[7] = a1.w * qs;
          gk[0] = b0.x; gk[1] = b0.y; gk[2] = b0.z; gk[3] = b0.w; gk[4] = b1.x; gk[5] = b1.y; gk[6] = b1.z; gk[7] = b1.w; }
        const int colk = (g4 < 2) ? (PC_KS + 128 * g4) : (PC_KW + 128 * (g4 - 2));
        bf16_t* Pw = P + (size_t)gw * 8 * PWID + 8 * sub;
#pragma unroll
        for (int k = 0; k < 3; ++k) {
            const int col = (k < 2) ? (PC_Q + 128 * (g4 + 4 * k)) : colk;
#pragma unroll
            for (int tq = 0; tq < 2; ++tq) {
                u32x4 raw[4];
#pragma unroll
                for (int j = 0; j < 4; ++j) raw[j] = *(const u32x4*)(Pw + (size_t)(tq * 4 + j) * PWID + col);
#pragma unroll
                for (int j = 0; j < 4; ++j) {
                    const u32x4 rw = raw[j];
                    float f[8] = {bflo(rw.x), bfhi(rw.x), bflo(rw.y), bfhi(rw.y), bflo(rw.z), bfhi(rw.z), bflo(rw.w), bfhi(rw.w)};
                    float s = 0.f;
#pragma unroll
                    for (int e = 0; e < 8; ++e) s += f[e] * f[e];
                    s += __shfl_xor(s, 1); s += __shfl_xor(s, 2); s += __shfl_xor(s, 4); s += __shfl_xor(s, 8);
                    const float rstd = rsqrtf(s * (1.f / 128.f) + 1e-6f);
                    u32x4 o;
                    if (k < 2) { o.x = pk2(f[0] * rstd * gq[0], f[1] * rstd * gq[1]); o.y = pk2(f[2] * rstd * gq[2], f[3] * rstd * gq[3]); o.z = pk2(f[4] * rstd * gq[4], f[5] * rstd * gq[5]); o.w = pk2(f[6] * rstd * gq[6], f[7] * rstd * gq[7]); }
                    else { o.x = pk2(f[0] * rstd * gk[0], f[1] * rstd * gk[1]); o.y = pk2(f[2] * rstd * gk[2], f[3] * rstd * gk[3]); o.z = pk2(f[4] * rstd * gk[4], f[5] * rstd * gk[5]); o.w = pk2(f[6] * rstd * gk[6], f[7] * rstd * gk[7]); }
                    *(u32x4*)(Pw + (size_t)(tq * 4 + j) * PWID + col) = o;
                }
            }
        }
    }
    {
        bf16_t* pooled = (bf16_t*)(p.ws + WS_POOLED);
        const int gw = bid * 8 + wave, NGW = G * 8, cc = lane & 31, half = lane >> 5;
        for (int wi = gw; wi < 4 * (M / 8); wi += NGW) {
            const int gi = (wi + (wi >> 11)) & 3, tq = wi >> 2; const size_t m0 = (size_t)tq * 8 + 4 * half; const int c8 = gi * 256 + cc * 8;
            if (gi == 0) pool_item<2>(P, pooled, m0, c8); else if (gi == 1) pool_item<4>(P, pooled, m0, c8); else if (gi == 2) pool_item<8>(P, pooled, m0, c8); else pool_item<16>(P, pooled, m0, c8);
        }
    }
}

namespace att {
constexpr int KST = 272, VST = 136;
constexpr int K_OFF = 0, V_OFF = 64 * KST, KV_BYTES = 64 * KST + 128 * VST, IMP_OFF = 2 * KV_BYTES, SEL_OFF = IMP_OFF + 64 * 64 * 4, UNI_OFF = SEL_OFF + 64 * 8, OUT_OFF = UNI_OFF + 64;
#define MFMA32(a, b, c) __builtin_amdgcn_mfma_f32_32x32x16_bf16((a), (b), (c), 0, 0, 0)

template <int MODE>
DI void branch(const int wv, LAS unsigned char* lds, const bf16x8 (&qf)[8], const char* kbase, const long ldk, const char* vbase, const long ldv,
               unsigned long long tiles, const unsigned long long wsel, const unsigned long long wall, const int qt, const int t_tok, const float sc_l2, const float sl_l2, const float m_fix,
               const unsigned long long selm, const float p_scale, float& l_run, f32x16 (&O)[4], LAS float* imp_row) {
    TID_FROM_WV(wv)
    const int lane = tid & 63, rr = lane & 31, h = lane >> 5;
    constexpr bool CMP = (MODE < 2);
    constexpr int KS = CMP ? 16 : 1;
    u32x4 kr[2], vr[2];
    float carry = 0.f;
#define ATT_LOAD(j) do { _Pragma("unroll") for (int _i = 0; _i < 2; ++_i) { const int _c = tid + 512 * _i; \
        kr[_i] = *(const u32x4*)(kbase + (size_t)(64 * (j) + (_c >> 4)) * ldk + (_c & 15) * 16); \
        if (MODE != 0) vr[_i] = *(const u32x4*)(vbase + (size_t)(_c >> 3) * ldv + (size_t)(j) * 128 + (_c & 7) * 16); } } while (0)
#define ATT_STORE(LB) do { _Pragma("unroll") for (int _i = 0; _i < 2; ++_i) { const int _c = tid + 512 * _i; \
        *(LAS u32x4*)((LB) + K_OFF + (_c >> 4) * KST + (_c & 15) * 16) = kr[_i]; \
        if (MODE != 0) { LAS u32x2* _d = (LAS u32x2*)((LB) + V_OFF + (_c >> 3) * VST + (_c & 7) * 16); _d[0] = (u32x2){vr[_i].x, vr[_i].y}; _d[1] = (u32x2){vr[_i].z, vr[_i].w}; } } } while (0)
    int j = __builtin_ctzll(tiles); tiles &= tiles - 1;
    LAS unsigned char* const lds0 = lds;
    ATT_LOAD(j); ATT_STORE(lds0);
    __syncthreads();
    int buf = 0;
    for (;;) {
        LAS unsigned char* const lds = lds0 + buf * KV_BYTES;
        const bool has_next = tiles != 0ull;
        int jn = j;
        if (has_next) { jn = __builtin_ctzll(tiles); tiles &= tiles - 1; ATT_LOAD(jn);
}
        if (MODE != 2 || ((wsel >> j) & 1ull)) {
        const int dbase = CMP ? (t_tok - 31 - 16 * (64 * j + 4 * h)) : (t_tok - 64 * j - 4 * h);
        const bool selbit = (MODE == 2) ? (((selm >> j) & 1ull) != 0ull) : true;
        const float b0 = selbit ? (-sl_l2 * (float)dbase - m_fix) : -1e30f;
        f32x16 X0, X1;
#pragma unroll
        for (int i = 0; i < 16; ++i) { X0[i] = __builtin_fmaf(sl_l2, (float)(KS * ((i & 3) + 8 * (i >> 2))), b0); X1[i] = __builtin_fmaf(sl_l2, (float)(KS * (32 + (i & 3) + 8 * (i >> 2))), b0); }
#pragma unroll
        for (int ks = 0; ks < 8; ++ks) {
            const bf16x8 k0 = *(const LAS bf16x8*)(lds + K_OFF + rr * KST + (16 * ks + 8 * h) * 2);
            X0 = MFMA32(k0, qf[ks], X0);
        }
#pragma unroll
        for (int ks = 0; ks < 8; ++ks) {
            const bf16x8 k1 = *(const LAS bf16x8*)(lds + K_OFF + (32 + rr) * KST + (16 * ks + 8 * h) * 2);
            X1 = MFMA32(k1, qf[ks], X1);
        }
        bool interior = false;
        if (MODE == 2) interior = (j < qt);
        if (MODE == 3) interior = (j < qt) && (j > qt - 8);
        float rs = 0.f;
#define ATT_SOFTMAX(X, SUB) do { \
        if (interior) { _Pragma("unroll") for (int i = 0; i < 16; ++i) { const float pv_ = fast_exp2(X[i]); X[i] = pv_; rs += pv_; } } \
        else { _Pragma("unroll") for (int i = 0; i < 16; ++i) { const int kc_ = KS * (32 * (SUB) + (i & 3) + 8 * (i >> 2)); \
            bool v_ = (dbase >= kc_) && selbit; if (MODE == 3) v_ = v_ && (dbase - kc_ < 512); \
            float pv_ = fast_exp2(X[i]); pv_ = v_ ? pv_ : 0.f; X[i] = pv_; rs += pv_; } } } while (0)
#define ATT_PV(X, SUB) do { _Pragma("unroll") for (int s = 0; s < 2; ++s) { \
        u32x4 pp; pp.x = pk2(X[8 * s], X[8 * s + 1]); pp.y = pk2(X[8 * s + 2], X[8 * s + 3]); pp.z = pk2(X[8 * s + 4], X[8 * s + 5]); pp.w = pk2(X[8 * s + 6], X[8 * s + 7]); \
        const bf16x8 pb = __builtin_bit_cast(bf16x8, pp); \
        _Pragma("unroll") for (int dt = 0; dt < 4; ++dt) { \
            const LAS unsigned char* va = lds + V_OFF + (32 * dt + rr) * VST + (32 * (SUB) + 16 * s + 4 * h) * 2; \
            const s16x4 lo = *(const LAS s16x4*)va, hi = *(const LAS s16x4*)(va + 16); \
            const bf16x8 vf = __builtin_shufflevector(lo, hi, 0, 1, 2, 3, 4, 5, 6, 7); \
            O[dt] = MFMA32(vf, pb, O[dt]); } } } while (0)
#define ATT_VLOAD(DST, SUB, S) do { _Pragma("unroll") for (int dt = 0; dt < 4; ++dt) { \
            const LAS unsigned char* va = lds + V_OFF + (32 * dt + rr) * VST + (32 * (SUB) + 16 * (S) + 4 * h) * 2; \
            const s16x4 lo = *(const LAS s16x4*)va, hi = *(const LAS s16x4*)(va + 16); \
            DST[dt] = __builtin_shufflevector(lo, hi, 0, 1, 2, 3, 4, 5, 6, 7); } } while (0)
#define ATT_PVS(X, S, VF) do { u32x4 pp; pp.x = pk2(X[8 * (S)], X[8 * (S) + 1]); pp.y = pk2(X[8 * (S) + 2], X[8 * (S) + 3]); pp.z = pk2(X[8 * (S) + 4], X[8 * (S) + 5]); pp.w = pk2(X[8 * (S) + 6], X[8 * (S) + 7]); \
        const bf16x8 pb = __builtin_bit_cast(bf16x8, pp); \
        _Pragma("unroll") for (int dt = 0; dt < 4; ++dt) O[dt] = MFMA32(VF[dt], pb, O[dt]); } while (0)
        ATT_SOFTMAX(X0, 0);
        if (MODE >= 2) ATT_PV(X0, 0);
        ATT_SOFTMAX(X1, 1);
        if (MODE >= 2) ATT_PV(X1, 1);
        if (MODE != 1) l_run += rs;
        else {
#pragma unroll
            for (int i = 0; i < 16; ++i) { X0[i] *= p_scale; X1[i] *= p_scale; }
#pragma unroll
            for (int sub = 0; sub < 2; ++sub) {
                float A[4], L[4], tL[4], own[4];
#pragma unroll
                for (int gq = 0; gq < 4; ++gq) { const float a0 = sub ? X1[4 * gq] : X0[4 * gq], a1 = sub ? X1[4 * gq + 1] : X0[4 * gq + 1], a2 = sub ? X1[4 * gq + 2] : X0[4 * gq + 2], a3 = sub ? X1[4 * gq + 3] : X0[4 * gq + 3];
                    A[gq] = (a0 + a1) + (a2 + a3); L[gq] = a3; }
#pragma unroll
                for (int gq = 0; gq < 4; ++gq) tL[gq] = __shfl_xor(L[gq], 32);
                own[0] = A[0] + (h ? tL[0] : carry);
#pragma unroll
                for (int gq = 1; gq < 4; ++gq) own[gq] = A[gq] + (h ? tL[gq] : tL[gq - 1]);
                carry = tL[3];
#pragma unroll
                for (int gq = 0; gq < 4; ++gq) { float v = own[gq]; v += __shfl_xor(v, 1); v += __shfl_xor(v, 2); own[gq] = v; }
                if ((lane & 3) == 0) {
#pragma unroll
                    for (int gq = 0; gq < 4; ++gq) imp_row[16 * j + 8 * sub + 2 * gq + h] = own[gq]; }
            }
            ATT_PV(X0, 0); ATT_PV(X1, 1);
        }
#undef ATT_SOFTMAX
#undef ATT_PV
#undef ATT_VLOAD
#undef ATT_PVS
        }
        if (!has_next) break;
        ATT_STORE(lds0 + (buf ^ 1) * KV_BYTES);
        __syncthreads();
        buf ^= 1; j = jn;
    }
    __syncthreads();
#undef ATT_LOAD
#undef ATT_STORE
}

DI float wave_max(float v) {
#pragma unroll
    for (int o = 1; o < 64; o <<= 1) v = fmaxf(v, __shfl_xor(v, o));
    return v;
}
DI void unit(const int wv, const Params& p, int l, int b, int g, int qt, LAS unsigned char* lds) {
    TID_FROM_WV(wv)
    const int lane = tid & 63, wave = tid >> 6, rr = lane & 31, h = lane >> 5, r = lane & 3, tl = rr >> 2;
    const bf16_t* P = (const bf16_t*)(p.ws + WS_P); const bf16_t* Vt = (const bf16_t*)(p.ws + WS_VT);
    const int tok_l = 8 * wave + tl, t_tok = 64 * qt + tok_l, head = g * 4 + r; const unsigned m = (unsigned)(b * T + t_tok);
    LAS float* imp = (LAS float*)(lds + IMP_OFF); LAS unsigned long long* selw = (LAS unsigned long long*)(lds + SEL_OFF); LAS unsigned long long* uniw = (LAS unsigned long long*)(lds + UNI_OFF);
    bf16x8 qf[8];
    { const bf16_t* qp = P + (size_t)(m * (unsigned)PWID + PC_Q + head * 128 + 8 * h);
#pragma unroll
      for (int ks = 0; ks < 8; ++ks) qf[ks] = *(const bf16x8*)(qp + 16 * ks); }
    const float sc_l2 = 0.08838834764831845f * 1.44269504f;
    const float sl_l2 = __builtin_amdgcn_exp2f(-(float)(head + 1)) * 1.44269504f;
    float qn;
    { float s = 0.f;
#pragma unroll
      for (int ks = 0; ks < 8; ++ks)
#pragma unroll
          for (int e = 0; e < 8; ++e) { const float f = bf2f((unsigned short)qf[ks][e]); s += f * f; }
      s += __shfl_xor(s, 32); qn = sqrtf(s) * (11.313708499f * 1.02f); }
#define ATT_GK(k) wave_max(fmaxf(fabsf(p.k_gain[(l * 3 + (k)) * 128 + lane]), fabsf(p.k_gain[(l * 3 + (k)) * 128 + lane + 64])))
#define ATT_GL(k) bf2f(Vt[(unsigned)(VR_GL + head * 3 + (k)) * (unsigned)M + m])
    for (int i = tid; i < 64 * 64; i += 512) imp[i] = 0.f;
    __syncthreads();
    f32x16 O[4]; LAS unsigned* outp = (LAS unsigned*)(lds + OUT_OFF) + wave * 2048 + lane;
    const char* kc_base = (const char*)(p.ws + WS_KCMP) + ((size_t)b * 2 + g) * 256 * 256;
    const char* vc_base = (const char*)(p.ws + WS_VCMP) + ((size_t)b * 2 + g) * 128 * 512;
    const int nct = (4 * qt + 2) / 64 + 1;
    const unsigned long long ctiles = (1ull << nct) - 1ull;
    float l_c = 0.f;
    branch<0>(wv, lds, qf, kc_base, 256, vc_base, 512, ctiles, ~0ull, 0ull, qt, t_tok, sc_l2, sl_l2, qn * ATT_GK(0), 0ull, 0.f, l_c, O, imp + tok_l * 64);
    { const float lt = l_c + __shfl_xor(l_c, 32); l_c = (lt > 0.f) ? 1.f / lt : 0.f; }
#pragma unroll
    for (int dt = 0; dt < 4; ++dt)
#pragma unroll
        for (int i = 0; i < 16; ++i) O[dt][i] = 0.f;
    { float dummy = 0.f;
      branch<1>(wv, lds, qf, kc_base, 256, vc_base, 512, ctiles, ~0ull, 0ull, qt, t_tok, sc_l2, sl_l2, qn * ATT_GK(0), 0ull, l_c, dummy, O, imp + tok_l * 64); }
    { const float gt = sigmoid_f(ATT_GL(0));
#pragma unroll
      for (int dt = 0; dt < 4; ++dt)
#pragma unroll
          for (int i = 0; i < 8; ++i) outp[(dt * 8 + i) * 64] = pk2(gt * O[dt][2 * i], gt * O[dt][2 * i + 1]); }
    __syncthreads();
    unsigned long long wuni = 0ull, wall = ~0ull;
    {
        for (int t8 = 0; t8 < 8; ++t8) {
            const float v = imp[(8 * wave + t8) * 64 + lane];
            const bool valid = lane <= qt, forced = (lane == 0) || (lane == qt) || (lane == qt - 1);
            const float sc = valid ? (v + (forced ? 1000.f : 0.f)) : -1e30f;
            int rank = 0;
#pragma unroll 4
            for (int jj = 0; jj <= qt; ++jj) {        const float sj = __builtin_bit_cast(float, __builtin_amdgcn_readlane(__builtin_bit_cast(int, sc), jj)); rank += ((sj > sc) || (sj == sc && jj < lane)) ? 1 : 0; }
            const unsigned long long sel = __ballot((rank < 16) && valid);
            if (lane == 0) selw[8 * wave + t8] = sel;
            wuni |= sel; wall &= sel;
        }
        if (lane == 0) uniw[wave] = wuni;
    }
    __syncthreads();
    unsigned long long uni = 0ull;
#pragma unroll
    for (int w = 0; w < 8; ++w) uni |= uniw[w];
    const unsigned long long selm = selw[tok_l];
    {
        const char* kb = (const char*)(P + (size_t)b * T * PWID + PC_KS + g * 128);
        const char* vb = (const char*)(Vt + (size_t)(VR_VS + g * 128) * M + (size_t)b * T);
        float lr = 0.f;
#pragma unroll
        for (int dt = 0; dt < 4; ++dt)
#pragma unroll
            for (int i = 0; i < 16; ++i) O[dt][i] = 0.f;
        branch<2>(wv, lds, qf, kb, (long)PWID * 2, vb, (long)M * 2, uni, wuni, wall, qt, t_tok, sc_l2, sl_l2, qn * ATT_GK(1), selm, 0.f, lr, O, nullptr);
        const float lt = lr + __shfl_xor(lr, 32); const float gt = sigmoid_f(ATT_GL(1)) * ((lt > 0.f) ? 1.f / lt : 0.f);
#pragma unroll
        for (int dt = 0; dt < 4; ++dt)
#pragma unroll
            for (int i = 0; i < 8; ++i) { const unsigned pv = outp[(dt * 8 + i) * 64]; outp[(dt * 8 + i) * 64] = pk2(bflo(pv) + gt * O[dt][2 * i], bfhi(pv) + gt * O[dt][2 * i + 1]); }
    }
    {
        const char* kb = (const char*)(P + (size_t)b * T * PWID + PC_KW + g * 128);
        const char* vb = (const char*)(Vt + (size_t)(VR_VW + g * 128) * M + (size_t)b * T);
        const int j0 = (qt >= 8) ? qt - 8 : 0;
        const unsigned long long wt = ((qt == 63) ? ~0ull : ((1ull << (qt + 1)) - 1ull)) & ~((1ull << j0) - 1ull);
        float lr = 0.f;
#pragma unroll
        for (int dt = 0; dt < 4; ++dt)
#pragma unroll
            for (int i = 0; i < 16; ++i) O[dt][i] = 0.f;
        branch<3>(wv, lds, qf, kb, (long)PWID * 2, vb, (long)M * 2, wt, ~0ull, 0ull, qt, t_tok, sc_l2, sl_l2, qn * ATT_GK(2), 0ull, 0.f, lr, O, nullptr);
        const float lt = lr + __shfl_xor(lr, 32); const float gt = sigmoid_f(ATT_GL(2)) * ((lt > 0.f) ? 1.f / lt : 0.f);
#pragma unroll
        for (int dt = 0; dt < 4; ++dt)
#pragma unroll
            for (int i = 0; i < 8; ++i) { const unsigned pv = outp[(dt * 8 + i) * 64]; outp[(dt * 8 + i) * 64] = pk2(bflo(pv) + gt * O[dt][2 * i], bfhi(pv) + gt * O[dt][2 * i + 1]); }
    }
    bf16_t* op = (bf16_t*)(p.ws + WS_CONCAT) + (size_t)(m * (unsigned)D + 1024 + head * 128 + 4 * h);
#pragma unroll
    for (int dt = 0; dt < 4; ++dt)
#pragma unroll
        for (int gq = 0; gq < 4; ++gq) { u32x2 w; w.x = outp[(dt * 8 + 2 * gq) * 64]; w.y = outp[(dt * 8 + 2 * gq + 1) * 64];
            *(u32x2*)(op + 32 * dt + 8 * gq) = w; }
}
static_assert(OUT_OFF + 8 * 2048 * 4 <= LDS_BYTES - 256, "attention LDS map");
}


#define XB_TMO      128
#define XB_XCNT(j)  (256  + 64 * (j))
#define XB_XSUB(j)  (1280 + 64 * (j))
#define XB_XGEN(j)  (2304 + 64 * (j))
#define XB_TOP      3328
#define XB_TOPGEN   3392
#define XCD_BAR_WORDS 3456
#define XB_SPIN_CAP (1u << 18)
DI unsigned xb_ld(unsigned* p)              { return __hip_atomic_load(p, __ATOMIC_RELAXED, __HIP_MEMORY_SCOPE_AGENT); }
DI unsigned xb_add(unsigned* p, unsigned v) { return __hip_atomic_fetch_add(p, v, __ATOMIC_RELAXED, __HIP_MEMORY_SCOPE_AGENT); }
DI unsigned xb_xcc_id() { return (unsigned)__builtin_amdgcn_s_getreg((3 << 11) | 20) & 0xFu; }
#define XB_SPIN(cond, bar) do { unsigned _sp = 0; while (cond) { __builtin_amdgcn_s_sleep(1); \
    if ((++_sp & 255u) == 0u) { if (xb_ld(&(bar)[XB_TMO])) break; if (_sp > XB_SPIN_CAP) { atomicAdd(&(bar)[XB_TMO], 1u); break; } } } } while (0)
struct XcdBarrier { unsigned* bar; unsigned x; volatile LAS unsigned* st; };
DI XcdBarrier xcd_barrier_post(const int wv, unsigned* bar, volatile LAS unsigned* st) {
    XcdBarrier b; b.bar = bar; b.x = xb_xcc_id(); b.st = st;
    if (wv == 0 && lane_id_() == 0) (void)xb_add(&bar[XB_XCNT(b.x)], 1u);
    return b;
}
DI void xcd_barrier_complete(unsigned* bar, unsigned x, unsigned& nloc, unsigned& nx) {
    const unsigned G = GRID;
    unsigned sum, cnt, mine, sp = 0u;
    for (;;) {
        sum = 0u; cnt = 0u; mine = 0u;
#pragma unroll
        for (unsigned j = 0; j < 16; ++j) { const unsigned c = xb_ld(&bar[XB_XCNT(j)]); sum += c; cnt += (c > 0u) ? 1u : 0u; }
        if (sum == G) { mine = xb_ld(&bar[XB_XCNT(x)]); break; }
        __builtin_amdgcn_s_sleep(1);
        if ((++sp & 255u) == 0u) { if (xb_ld(&bar[XB_TMO])) break; if (sp > XB_SPIN_CAP) { atomicAdd(&bar[XB_TMO], 1u); break; } }
    }
    nloc = mine > 0u ? mine : 1u; nx = cnt > 0u ? cnt : 1u;
}
DI void xcd_barrier(const int wv, const XcdBarrier& b) {
    asm volatile("s_waitcnt vmcnt(0)" ::: "memory");
    __syncthreads();
    if (wv == 0 && lane_id_() == 0) {
        unsigned* bar = b.bar;
        __builtin_amdgcn_s_waitcnt(0);
        unsigned nloc = b.st[0], nx = b.st[1];
        if (nloc == 0u) { xcd_barrier_complete(bar, b.x, nloc, nx); b.st[0] = nloc; b.st[1] = nx; }
        const unsigned old = xb_add(&bar[XB_XSUB(b.x)], 1u);
        const unsigned gen = old / nloc;
        if (old + 1u == (gen + 1u) * nloc) {
            __builtin_amdgcn_fence(__ATOMIC_RELEASE, "agent");
            asm volatile("s_waitcnt vmcnt(0)" ::: "memory");
            const unsigned og = xb_add(&bar[XB_TOP], 1u);
            const unsigned tg = og / nx;
            if (og + 1u == (tg + 1u) * nx) xb_add(&bar[XB_TOPGEN], 1u);
            else XB_SPIN(xb_ld(&bar[XB_TOPGEN]) == tg, bar);
            __builtin_amdgcn_fence(__ATOMIC_ACQUIRE, "agent");
            xb_add(&bar[XB_XGEN(b.x)], 1u);
            asm volatile("s_waitcnt vmcnt(0)" ::: "memory");
        } else {
            XB_SPIN(xb_ld(&bar[XB_XGEN(b.x)]) == gen, bar);
            __builtin_amdgcn_fence(__ATOMIC_ACQUIRE, "agent");
            asm volatile("s_waitcnt vmcnt(0)" ::: "memory");
        }
    }
    __syncthreads();
}

DI unsigned char* opaque_ptr(unsigned char* q) { asm volatile("" : "+s"(q)); return q; }
__global__ void __launch_bounds__(512, 2) mega(Params p) {
    extern __shared__ __attribute__((aligned(16))) unsigned char lds_raw[];
    LAS unsigned char* lds = (LAS unsigned char*)lds_raw;
    cg::grid_group grid = cg::this_grid();
    const int wv = __builtin_amdgcn_readfirstlane((int)threadIdx.x >> 6);
    const int G = GRID, bid = blockIdx.x;
#define IN(k) (p.ph_lo <= (k) && (k) < p.ph_hi)
#define SEAM(k) do { if (IN(k) && IN((k) + 1)) xcd_barrier(wv, bar); } while (0)
    volatile LAS unsigned* MISC = (volatile LAS unsigned*)(lds + LDS_BYTES - 256);
    if (wv == 0 && lane_id_() < 16) MISC[lane_id_()] = 0u;
    __syncthreads();
    XcdBarrier bar; bar.bar = (unsigned*)(p.ws + WS_BAR); bar.x = 0; bar.st = MISC;
    if (p.ph_hi < 0) grid.sync();
    if (p.ph_hi - p.ph_lo > 1) bar = xcd_barrier_post(wv, (unsigned*)(p.ws + WS_BAR), MISC);
    if (IN(0)) phase0(wv, p, lds);
    SEAM(0);
    for (int l = 0; l < DEPTH; ++l) {
        const int pb = 1 + 8 * l;
#define WL_(wq) ((wq) + WS_W + (size_t)l * WL)
#define MODL_(wq) ((const float*)((wq) + WS_MOD) + (size_t)l * 4 * MODW)
        if (IN(pb + 0)) { unsigned char* const wq = opaque_ptr(p.ws);
            norm_phase(wv, (l == 0) ? p.x : (const float*)p.out, p.norm_g + (size_t)(l * 2 + 0) * D, MODL_(wq) + 0 * D, MODL_(wq) + 1 * D, (bf16_t*)(wq + WS_H)); }
        SEAM(pb + 0);
        if (IN(pb + 1)) { unsigned char* const wq = opaque_ptr(p.ws);
            pg8::SchedProj S; S.o.init(64, 15, G, bid); S.h = (const char*)(wq + WS_H); S.w = (const char*)(WL_(wq) + WO_IN);
            pg8::EpiProj E{(bf16_t*)(wq + WS_P), (bf16_t*)(wq + WS_VT)};
            pg8::gemm_phase(wv, lds, 4096, 4096, D, S, E);
        }
        SEAM(pb + 1);
        if (IN(pb + 2)) prep_phase(wv, p, l, lds);
        SEAM(pb + 2);
        if (IN(pb + 3)) { unsigned char* const wq = opaque_ptr(p.ws);
            volatile LAS int* unext = (volatile LAS int*)(lds + LDS_BYTES - 256 + 64);
            unsigned* ctr = (unsigned*)(wq + WS_BAR) + 3584 + 64 * l;
            for (;;) {
                __syncthreads();
                if (wv == 0 && lane_id_() == 0) *unext = (int)__hip_atomic_fetch_add(ctr, 1u, __ATOMIC_RELAXED, __HIP_MEMORY_SCOPE_AGENT);
                __syncthreads();
                const int u = *unext;
                if (u >= 768) break;
                if (u < 512) { const int g = (u < 256) ? 1 : 0, qt = 63 - ((u & 255) >> 2), b = u & 3;
                    att::unit(wv, p, l, b, g, qt, lds); }
                else {
                    pg8::SchedPoolOne S{(u - 512) >> 2, (u - 512) & 3, (const char*)(wq + WS_POOLED), (const char*)(WL_(wq) + WO_POOL)};
                    pg8::EpiPool E{(bf16_t*)(wq + WS_CONCAT)};
                    pg8::gemm_phase(wv, lds, 2048, 512, 256, S, E); }
            }
            __syncthreads();
        }
        SEAM(pb + 3);
        if (IN(pb + 4)) { unsigned char* const wq = opaque_ptr(p.ws);
            pg8::SchedPlain S; S.o.init(64, 8, G, bid); S.A = (const char*)(wq + WS_CONCAT); S.B = (const char*)(WL_(wq) + WO_OUT); S.tsA = 256 * 4096; S.tsB = 256 * 4096;
            pg8::EpiResid E{(l == 0) ? p.x : (const float*)p.out, p.out, MODL_(wq) + 2 * D};
            pg8::gemm_phase(wv, lds, 4096, 4096, D, S, E);
        }
        SEAM(pb + 4);
        if (IN(pb + 5)) { unsigned char* const wq = opaque_ptr(p.ws);
            norm_phase(wv, p.out, p.norm_g + (size_t)(l * 2 + 1) * D, MODL_(wq) + 3 * D, MODL_(wq) + 4 * D, (bf16_t*)(wq + WS_H)); }
        SEAM(pb + 5);
        if (IN(pb + 6)) { unsigned char* const wq = opaque_ptr(p.ws);
            pg8::SchedPlain S; S.o.init(64, 44, G, bid); S.A = (const char*)(wq + WS_H); S.B = (const char*)(WL_(wq) + WO_GU); S.tsA = 256 * 4096; S.tsB = 256 * 4096;
            pg8::EpiSwiglu E{(bf16_t*)(wq + WS_ACT)};
            pg8::gemm_phase(wv, lds, 4096, 4096, D, S, E);
        }
        SEAM(pb + 6);
        if (IN(pb + 7)) { unsigned char* const wq = opaque_ptr(p.ws);
            pg8::SchedPlain S; S.o.init(64, 8, G, bid); S.A = (const char*)(wq + WS_ACT); S.B = (const char*)(WL_(wq) + WO_DOWN); S.tsA = (size_t)256 * DFF * 2; S.tsB = (size_t)256 * DFF * 2;
            pg8::EpiResid E{p.out, p.out, MODL_(wq) + 5 * D};
            pg8::gemm_phase(wv, lds, DFF * 2, DFF * 2, DFF, S, E);
        }
        SEAM(pb + 7);
#undef WL_
#undef MODL_
    }
#undef IN
#undef SEAM
}


extern "C" void kernel_launch(void* const* d_in, const int* in_sizes, int n_in, void* d_out, int out_size, void* d_ws, size_t ws_size, hipStream_t stream) {
    static int grid = 0;
    if (grid == 0) {
        if (n_in != 16 || in_sizes[0] != M * D || out_size != M * D || ws_size < WS_END) {
            fprintf(stderr, "kernel_launch: unexpected shapes: n_in %d in0 %d out %d ws %zu (need %zu)\n", n_in, n_in > 0 ? in_sizes[0] : -1, out_size, ws_size, (size_t)WS_END); grid = -1; return; }
        int dev = 0, cus = 0, per_cu = 0;
        (void)hipGetDevice(&dev);
        (void)hipDeviceGetAttribute(&cus, hipDeviceAttributeMultiprocessorCount, dev);
        if (hipFuncSetAttribute((const void*)mega, hipFuncAttributeMaxDynamicSharedMemorySize, LDS_BYTES) != hipSuccess) { fprintf(stderr, "kernel_launch: hipFuncSetAttribute failed\n"); grid = -1; return; }
        if (hipOccupancyMaxActiveBlocksPerMultiprocessor(&per_cu, (const void*)mega, 512, LDS_BYTES) != hipSuccess || per_cu < 1) { fprintf(stderr, "kernel_launch: occupancy query gives %d\n", per_cu); per_cu = 1; }
        (void)hipGetLastError();
        if (cus * per_cu < GRID) fprintf(stderr, "kernel_launch: the device reports room for %d workgroups, the kernel is built for %d\n", cus * per_cu, GRID);
        grid = GRID;
    }
    if (grid < 0) return;
    if (hipMemsetAsync((char*)d_ws + WS_BAR, 0, 16384, stream) != hipSuccess) { fprintf(stderr, "kernel_launch: hipMemsetAsync failed\n"); return; }
    Params p{};
    p.x = (const float*)d_in[0]; p.c = (const float*)d_in[1]; p.w_ada = (const float*)d_in[2]; p.b_ada = (const float*)d_in[3]; p.norm_g = (const float*)d_in[4];
    p.w_in = (const float*)d_in[5]; p.q_gain = (const float*)d_in[6]; p.k_gain = (const float*)d_in[7]; p.pe_cmp = (const float*)d_in[8]; p.w_cmp1 = (const float*)d_in[9];
    p.w_cmp2 = (const float*)d_in[10]; p.w_pool = (const float*)d_in[11]; p.pool_scale = (const float*)d_in[12]; p.w_out = (const float*)d_in[13]; p.w_gate_up = (const float*)d_in[14];
    p.w_down = (const float*)d_in[15]; p.out = (float*)d_out; p.ws = (unsigned char*)d_ws;
#if MK_SINGLE
    p.ph_lo = 0; p.ph_hi = NPH;
    void* args[] = {&p};
    hipError_t e = hipLaunchCooperativeKernel((const void*)mega, dim3(grid), dim3(512), args, LDS_BYTES, stream);
    if (e != hipSuccess) fprintf(stderr, "kernel_launch: cooperative launch failed: %s (grid %d)\n", hipGetErrorString(e), grid);
#else
    for (int ph = 0; ph < NPH; ++ph) {
        p.ph_lo = ph; p.ph_hi = ph + 1;
        hipLaunchKernelGGL(mega, dim3(grid), dim3(512), LDS_BYTES, stream, p);
    }
#endif
}
```
